# Optimizing an MI355X kernel written in HIP

```python
import jax, jax.numpy as jnp
from jax import lax
import numpy as np

D_MODEL = 1024
BATCH = 8
SEQ = 4096
DEPTH = 2

CHUNK = 64
EPS = 1e-6
N_EVEN = (DEPTH + 1) // 2
N_ODD = DEPTH // 2

POOL_WINDOWS = (2, 4, 8, 16)
N_POOL_GROUPS = len(POOL_WINDOWS)
POOL_GROUP_DIM = D_MODEL // 8
POOL_WIDTH = N_POOL_GROUPS * POOL_GROUP_DIM

ATT_HEADS = 8
ATT_HEAD_DIM = 64
ATT_WIDTH = ATT_HEADS * ATT_HEAD_DIM
LEFT_CHUNKS = 8
LEFT = LEFT_CHUNKS * CHUNK
BAND = (LEFT_CHUNKS + 1) * CHUNK
MAX_REL = 128
N_REL = 2 * MAX_REL + 1
ATT_SCALE = ATT_HEAD_DIM ** -0.5
AB_IN_WIDTH = POOL_WIDTH + 3 * ATT_WIDTH
AB_MIX_WIDTH = POOL_WIDTH + ATT_WIDTH

SGU_CHUNK = 128
SGU_HEADS = 8
SGU_WIDTH = D_MODEL
SGU_HEAD_DIM = SGU_WIDTH // SGU_HEADS

N_GROUPS = 4
EXPERTS_PER_GROUP = 4
N_EXPERTS = N_GROUPS * EXPERTS_PER_GROUP
TOP_K_IN_GROUP = 2
D_EXPERT = 256

kernel_name = "hybrid_pool_chunkattn_gmlp_hmoe"


def rmsnorm(x, g):
    xf = x.astype(jnp.float32)
    y = xf * lax.rsqrt(jnp.mean(xf * xf, axis=-1, keepdims=True) + EPS) * g.astype(jnp.float32)
    return y.astype(x.dtype)


def layernorm(x, g, b):
    xf = x.astype(jnp.float32)
    mu = jnp.mean(xf, axis=-1, keepdims=True)
    var = jnp.mean(jnp.square(xf - mu), axis=-1, keepdims=True)
    y = (xf - mu) * lax.rsqrt(var + EPS) * g.astype(jnp.float32) + b.astype(jnp.float32)
    return y.astype(x.dtype)


def pool_mixer(p, w_pool, pool_scale):
    b_, s_, _ = p.shape
    pf = p.astype(jnp.float32).reshape(b_, s_, N_POOL_GROUPS, POOL_GROUP_DIM)
    cs = jnp.cumsum(pf, axis=1)
    cs = jnp.concatenate([jnp.zeros_like(cs[:, :1]), cs], axis=1)
    t = jnp.arange(s_)
    means = []
    for gi, w in enumerate(POOL_WINDOWS):
        start = jnp.maximum(t + 1 - w, 0)
        cnt = (t + 1 - start).astype(jnp.float32)
        cs_g = cs[:, :, gi]
        means.append((cs_g[:, 1:] - cs_g[:, start]) / cnt[None, :, None])
    pooled = jnp.stack(means, axis=2) - pf
    y = jnp.einsum('bsgc,gcd->bsgd', pooled, w_pool.astype(jnp.float32))
    y = y * pool_scale.astype(jnp.float32).reshape(N_POOL_GROUPS, POOL_GROUP_DIM)
    return y.reshape(b_, s_, POOL_WIDTH).astype(p.dtype)


def chunk_attention(q, k, v, rel_bias):
    b_, s_, h_, d_ = q.shape
    nc = s_ // CHUNK
    kp = jnp.pad(k, ((0, 0), (LEFT, 0), (0, 0), (0, 0)))
    vp = jnp.pad(v, ((0, 0), (LEFT, 0), (0, 0), (0, 0)))
    q_blocks = q.reshape(b_, nc, CHUNK, h_, d_).transpose(1, 0, 2, 3, 4)
    rel = jnp.arange(BAND)[None, :] - LEFT - jnp.arange(CHUNK)[:, None]
    bias = rel_bias.astype(jnp.float32)[:, jnp.clip(rel, -MAX_REL, MAX_REL) + MAX_REL]
    band_off = jnp.arange(BAND) - LEFT

    def one_chunk(args):
        c, qb = args
        kb = lax.dynamic_slice_in_dim(kp, c * CHUNK, BAND, axis=1)
        vb = lax.dynamic_slice_in_dim(vp, c * CHUNK, BAND, axis=1)
        s = jnp.einsum('bqhd,bkhd->bhqk', qb, kb).astype(jnp.float32) * ATT_SCALE + bias[None]
        valid = (c * CHUNK + band_off) >= 0
        s = jnp.where(valid[None, None, None, :], s, -1e30)
        pr = jax.nn.softmax(s, axis=-1)
        return jnp.einsum('bhqk,bkhd->bqhd', pr.astype(vb.dtype), vb)

    o = lax.map(one_chunk, (jnp.arange(nc), q_blocks))
    return o.transpose(1, 0, 2, 3, 4).reshape(b_, s_, h_ * d_)


def pool_attn_mixer(h, w_in, w_pool, pool_scale, rel_bias, w_out):
    b_, s_, _ = h.shape
    z = h @ w_in
    p = z[..., :POOL_WIDTH]
    q, k, v = jnp.split(z[..., POOL_WIDTH:], 3, axis=-1)
    shp = (b_, s_, ATT_HEADS, ATT_HEAD_DIM)
    a_out = pool_mixer(p, w_pool, pool_scale)
    b_out = chunk_attention(q.reshape(shp), k.reshape(shp), v.reshape(shp), rel_bias)
    return jnp.concatenate([a_out.astype(h.dtype), b_out.astype(h.dtype)], axis=-1) @ w_out


def sgu_mixer(h, w_in, b_in, ln_g, ln_b, w_s, b_s, w_out):
    b_, s_, _ = h.shape
    z = jax.nn.gelu(h @ w_in + b_in, approximate=False)
    u, v = jnp.split(z, 2, axis=-1)
    v = layernorm(v, ln_g, ln_b)
    nch = s_ // SGU_CHUNK
    vc = v.reshape(b_, nch, SGU_CHUNK, SGU_HEADS, SGU_HEAD_DIM)
    causal = jnp.tril(jnp.ones((SGU_CHUNK, SGU_CHUNK), dtype=w_s.dtype))
    ws = w_s * causal[None]
    mixed = jnp.einsum('hts,bnshd->bnthd', ws, vc) + b_s.T[None, None, :, :, None]
    return (u * mixed.reshape(b_, s_, SGU_WIDTH)) @ w_out


def hier_moe(h, wg_router, bg_router, we_router, be_router, w_gate, w_up, w_down):
    b_, s_, d_ = h.shape
    t = h.reshape(-1, d_)
    n = t.shape[0]
    g_logits = (t @ wg_router).astype(jnp.float32) + bg_router.astype(jnp.float32)
    g_prob = jax.nn.softmax(g_logits, axis=-1)
    g_top, g_idx = lax.top_k(g_logits, 1)
    g_w = jnp.take_along_axis(g_prob, g_idx, axis=-1)[:, 0]
    e_logits = jnp.einsum('nd,gde->nge', t, we_router).astype(jnp.float32) + be_router.astype(jnp.float32)
    e_sel = jnp.take_along_axis(e_logits, g_idx[:, :, None], axis=1)[:, 0]
    e_top, e_idx = lax.top_k(e_sel, TOP_K_IN_GROUP)
    e_w = jax.nn.softmax(e_top, axis=-1)
    expert_id = g_idx * EXPERTS_PER_GROUP + e_idx
    combine = jnp.sum(jax.nn.one_hot(expert_id, N_EXPERTS, dtype=jnp.float32)
                      * (g_w[:, None] * e_w)[..., None], axis=1)
    hg = jnp.einsum('nd,edf->nef', t, w_gate)
    hu = jnp.einsum('nd,edf->nef', t, w_up)
    act = jax.nn.silu(hg) * hu * combine.astype(t.dtype)[..., None]
    out = jnp.einsum('nef,efd->nd', act, w_down)
    return out.reshape(b_, s_, d_)


def setup_inputs(seed: int = 0) -> dict:
    key = jax.random.key(seed)
    ks = jax.random.split(key, 24)
    nrm = lambda k, shp: jax.random.normal(k, shp, dtype=jnp.float32)
    D = D_MODEL
    return {
        "x": nrm(ks[0], (BATCH, SEQ, D)),
        "norm_mix_g": 1.0 + 0.1 * nrm(ks[1], (DEPTH, D)),
        "norm_ffn_g": 1.0 + 0.1 * nrm(ks[2], (DEPTH, D)),
        "final_norm_g": 1.0 + 0.1 * nrm(ks[3], (D,)),
        "ab_w_in": nrm(ks[4], (N_EVEN, D, AB_IN_WIDTH)) * D ** -0.5,
        "pool_w": nrm(ks[5], (N_EVEN, N_POOL_GROUPS, POOL_GROUP_DIM, POOL_GROUP_DIM)) * POOL_GROUP_DIM ** -0.5,
        "pool_scale": 1.0 + 0.1 * nrm(ks[6], (N_EVEN, POOL_WIDTH)),
        "att_rel_bias": 0.1 * nrm(ks[7], (N_EVEN, ATT_HEADS, N_REL)),
        "ab_w_out": nrm(ks[8], (N_EVEN, AB_MIX_WIDTH, D)) * AB_MIX_WIDTH ** -0.5,
        "sgu_w_in": nrm(ks[9], (N_ODD, D, 2 * SGU_WIDTH)) * D ** -0.5,
        "sgu_b_in": 0.02 * nrm(ks[10], (N_ODD, 2 * SGU_WIDTH)),
        "sgu_ln_g": 1.0 + 0.1 * nrm(ks[11], (N_ODD, SGU_WIDTH)),
        "sgu_ln_b": 0.02 * nrm(ks[12], (N_ODD, SGU_WIDTH)),
        "sgu_w_s": nrm(ks[13], (N_ODD, SGU_HEADS, SGU_CHUNK, SGU_CHUNK)) * SGU_CHUNK ** -0.5,
        "sgu_b_s": 1.0 + 0.1 * nrm(ks[14], (N_ODD, SGU_HEADS, SGU_CHUNK)),
        "sgu_w_out": nrm(ks[15], (N_ODD, SGU_WIDTH, D)) * SGU_WIDTH ** -0.5,
        "moe_wg_router": nrm(ks[16], (DEPTH, D, N_GROUPS)) * D ** -0.5,
        "moe_bg_router": 0.01 * nrm(ks[17], (DEPTH, N_GROUPS)),
        "moe_we_router": nrm(ks[18], (DEPTH, N_GROUPS, D, EXPERTS_PER_GROUP)) * D ** -0.5,
        "moe_be_router": 0.01 * nrm(ks[19], (DEPTH, N_GROUPS, EXPERTS_PER_GROUP)),
        "moe_w_gate": nrm(ks[20], (DEPTH, N_EXPERTS, D, D_EXPERT)) * D ** -0.5,
        "moe_w_up": nrm(ks[21], (DEPTH, N_EXPERTS, D, D_EXPERT)) * D ** -0.5,
        "moe_w_down": nrm(ks[22], (DEPTH, N_EXPERTS, D_EXPERT, D)) * D_EXPERT ** -0.5,
    }


def reference(x, norm_mix_g, norm_ffn_g, final_norm_g,
              ab_w_in, pool_w, pool_scale, att_rel_bias, ab_w_out,
              sgu_w_in, sgu_b_in, sgu_ln_g, sgu_ln_b, sgu_w_s, sgu_b_s, sgu_w_out,
              moe_wg_router, moe_bg_router, moe_we_router, moe_be_router,
              moe_w_gate, moe_w_up, moe_w_down):
    h = x
    for layer in range(DEPTH):
        i = layer // 2
        y = rmsnorm(h, norm_mix_g[layer])
        if layer % 2 == 0:
            y = pool_attn_mixer(y, ab_w_in[i], pool_w[i], pool_scale[i], att_rel_bias[i], ab_w_out[i])
        else:
            y = sgu_mixer(y, sgu_w_in[i], sgu_b_in[i], sgu_ln_g[i], sgu_ln_b[i],
                          sgu_w_s[i], sgu_b_s[i], sgu_w_out[i])
        h = h + y
        y = hier_moe(rmsnorm(h, norm_ffn_g[layer]), moe_wg_router[layer], moe_bg_router[layer],
                     moe_we_router[layer], moe_be_router[layer],
                     moe_w_gate[layer], moe_w_up[layer], moe_w_down[layer])
        h = h + y
    return rmsnorm(h, final_norm_g)
```

```cpp
#include <hip/hip_runtime.h>
#include <cstdio>
#include <cstdint>

#ifndef MK_N_LAUNCHES
#define MK_N_LAUNCHES 1
#endif
#ifndef NAIVE_GEMM
#define NAIVE_GEMM 0
#endif
#ifndef NAIVE_ATTN
#define NAIVE_ATTN 1
#endif
#ifndef NAIVE_SGU
#define NAIVE_SGU 1
#endif

#define LAS __attribute__((address_space(3)))
#define GAS __attribute__((address_space(1)))
typedef unsigned short bf16_t;
typedef short bf16x8 __attribute__((ext_vector_type(8)));
typedef float f32x4 __attribute__((ext_vector_type(4)));
typedef float f32x2 __attribute__((ext_vector_type(2)));
typedef unsigned u32x4 __attribute__((ext_vector_type(4)));
typedef unsigned u32x2 __attribute__((ext_vector_type(2)));
typedef GAS unsigned gu32;
#define RLX_AGENT __ATOMIC_RELAXED, __HIP_MEMORY_SCOPE_AGENT

constexpr int NTOK = 32768, DM = 1024, SEQ = 4096, NBATCH = 8;
constexpr float EPS = 1e-6f, LOG2E = 1.4426950408889634f, C2 = 0.125f * 1.4426950408889634f;
constexpr int NBUCKET = 24, ACT_ROWS = NTOK + NBUCKET * 256, NPHASE = 15;

constexpr size_t MiB = 1u << 20;
constexpr size_t WS_CTL = 0, CTL_ZERO_BYTES = 1 * MiB;
constexpr size_t WS_BT_IN = 2 * MiB, WS_BT_OUT = 6 * MiB, WS_BT_SIN = 8 * MiB, WS_BT_SOUT = 12 * MiB, WS_WS = 14 * MiB;
constexpr size_t WS_GU = 16 * MiB  , WS_DN = 48 * MiB  ;
constexpr size_t WS_XN = 96 * MiB;
constexpr size_t WS_P = 160 * MiB, WS_Q = 192 * MiB, WS_K = 224 * MiB, WS_V = 256 * MiB;
constexpr size_t WS_U = 160 * MiB, WS_V1 = 224 * MiB;
constexpr size_t WS_MIX = 288 * MiB;
constexpr size_t WS_ACT = 352 * MiB;
constexpr size_t WS_TOK = 392 * MiB;
constexpr size_t WS_CW = 396 * MiB;
constexpr size_t WS_END = 404 * MiB;
constexpr int CW_CNT = 64;
constexpr int CW_BAR = 4096;

constexpr int RING_BYTES = 131072;
constexpr int MISC_OFF = RING_BYTES;
constexpr int TAB_OFF = RING_BYTES + 256;
constexpr int STASH_OFF = RING_BYTES + 2048;
constexpr int LDS_BYTES = 147456;

__device__ __forceinline__ unsigned f2bf(float f) { unsigned u = __builtin_bit_cast(unsigned, f); return (u + 0x7fffu + ((u >> 16) & 1u)) >> 16; }
__device__ __forceinline__ unsigned pk2(float lo, float hi) { return f2bf(lo) | (f2bf(hi) << 16); }
__device__ __forceinline__ float bf2f(unsigned short b) { return __builtin_bit_cast(float, (unsigned)b << 16); }
__device__ __forceinline__ float bflo(unsigned w) { return __builtin_bit_cast(float, w << 16); }
__device__ __forceinline__ float bfhi(unsigned w) { return __builtin_bit_cast(float, w & 0xffff0000u); }
__device__ __forceinline__ float wave_sum(float v) {
#pragma unroll
    for (int o = 1; o < 64; o <<= 1) v += __shfl_xor(v, o);
    return v;
}
__device__ __forceinline__ float wave_max(float v) {
#pragma unroll
    for (int o = 1; o < 64; o <<= 1) v = fmaxf(v, __shfl_xor(v, o));
    return v;
}
#define LDS_WAIT() asm volatile("s_waitcnt lgkmcnt(0)" ::: "memory")
__device__ __forceinline__ int pair_lo(int p) { return (0x211000 >> (4 * p)) & 0xF; }
__device__ __forceinline__ int pair_hi(int p) { return (0x332321 >> (4 * p)) & 0xF; }

__device__ __forceinline__ f32x2 gelu_pk(f32x2 v) {
    const f32x2 av = __builtin_elementwise_abs(v), d = av * 0.2316418882f + 1.0f;
    f32x2 t; t.x = __builtin_amdgcn_rcpf(d.x); t.y = __builtin_amdgcn_rcpf(d.y);
    f32x2 q = t * 0.5307027145f + (-0.7265760135f); q = q * t + 0.7107068705f; q = q * t + (-0.142248368f); q = q * t + 0.127414796f; q = q * t;
    const f32x2 s = (v * v) * (-0.72134752044f);
    f32x2 e; e.x = __builtin_amdgcn_exp2f(s.x); e.y = __builtin_amdgcn_exp2f(s.y);
    const f32x2 m = v * (q * e), r = v - m;
    f32x2 o; o.x = v.x < 0.f ? m.x : r.x; o.y = v.y < 0.f ? m.y : r.y; return o;
}
__device__ __forceinline__ f32x4 gelu4(f32x4 v) { f32x2 a = gelu_pk((f32x2){v[0], v[1]}), b = gelu_pk((f32x2){v[2], v[3]}); return (f32x4){a.x, a.y, b.x, b.y}; }
__device__ __forceinline__ float silu1(float x) { return x * __builtin_amdgcn_rcpf(1.0f + __builtin_amdgcn_exp2f(-x * LOG2E)); }

struct Args { const float* in[23]; float* out; unsigned char* ws; int ph_lo, ph_hi; };
__device__ __forceinline__ unsigned long long karg_u64(int byte_off) {
    asm volatile("" : "+s"(byte_off));
    const __attribute__((address_space(4))) unsigned char* kp = (const __attribute__((address_space(4))) unsigned char*)__builtin_amdgcn_kernarg_segment_ptr();
    const unsigned long long v = *(const __attribute__((address_space(4))) unsigned long long*)(kp + byte_off);
    const unsigned lo = __builtin_amdgcn_readfirstlane((unsigned)v), hi = __builtin_amdgcn_readfirstlane((unsigned)(v >> 32));
    return ((unsigned long long)hi << 32) | lo;
}
struct KA {
    __device__ __forceinline__ const float* in(int i) const { return (const float*)(const GAS float*)karg_u64(i * 8); }
    __device__ __forceinline__ float* out() const { return (float*)(GAS float*)karg_u64(23 * 8); }
    __device__ __forceinline__ unsigned char* ws() const { return (unsigned char*)(GAS unsigned char*)karg_u64(24 * 8); }
};
enum { I_X = 0, I_GMIX, I_GFFN, I_GFIN, I_WIN, I_POOLW, I_POOLS, I_RELB, I_WOUT, I_SWIN, I_SBIN, I_SLNG, I_SLNB, I_SWS, I_SBS, I_SWOUT,
       I_WGR, I_BGR, I_WER, I_BER, I_WG, I_WU, I_WD };

#define XB_TMO      128
#define XB_XCNT(j)  (256  + 64 * (j))
#define XB_XSUB(j)  (1280 + 64 * (j))
#define XB_XGEN(j)  (2304 + 64 * (j))
#define XB_TOP      3328
#define XB_TOPGEN   3392
#define XCD_BAR_WORDS 3456
#define XB_SPIN_CAP (1u << 18)
__device__ __forceinline__ unsigned xb_ld(unsigned* p)              { return __hip_atomic_load(p, __ATOMIC_RELAXED, __HIP_MEMORY_SCOPE_AGENT); }
__device__ __forceinline__ unsigned xb_add(unsigned* p, unsigned v) { return __hip_atomic_fetch_add(p, v, __ATOMIC_RELAXED, __HIP_MEMORY_SCOPE_AGENT); }
__device__ __forceinline__ unsigned xb_xcc_id() { return (unsigned)__builtin_amdgcn_s_getreg((3 << 11) | 20) & 0xFu; }
#define XB_SPIN(cond, bar) do { unsigned _sp = 0; while (cond) { __builtin_amdgcn_s_sleep(1); \
    if ((++_sp & 255u) == 0u) { if (xb_ld(&(bar)[XB_TMO])) break; if (_sp > XB_SPIN_CAP) { atomicAdd(&(bar)[XB_TMO], 1u); break; } } } } while (0)
struct XcdBarrier { unsigned* bar; unsigned x; volatile LAS unsigned* st; };
__device__ __forceinline__ XcdBarrier xcd_barrier_post(unsigned* bar, volatile LAS unsigned* st) {
    XcdBarrier b; b.bar = bar; b.x = xb_xcc_id(); b.st = st;
    if (threadIdx.x == 0) (void)xb_add(&bar[XB_XCNT(b.x)], 1u);
    return b;
}
__device__ __forceinline__ void xcd_barrier_complete(unsigned* bar, unsigned x, unsigned& nloc, unsigned& nx) {
    const unsigned G = gridDim.x * gridDim.y * gridDim.z;
    unsigned sum, cnt, mine, sp = 0u;
    for (;;) {
        sum = 0u; cnt = 0u; mine = 0u;
#pragma unroll
        for (unsigned j = 0; j < 16; ++j) { const unsigned c = xb_ld(&bar[XB_XCNT(j)]); sum += c; cnt += (c > 0u) ? 1u : 0u; mine = (j == x) ? c : mine; }
        if (sum == G) break;
        __builtin_amdgcn_s_sleep(1);
        if ((++sp & 255u) == 0u) { if (xb_ld(&bar[XB_TMO])) break; if (sp > XB_SPIN_CAP) { atomicAdd(&bar[XB_TMO], 1u); break; } }
    }
    nloc = mine > 0u ? mine : 1u; nx = cnt > 0u ? cnt : 1u;
}
__device__ __forceinline__ void xcd_barrier(const XcdBarrier& b) {
    asm volatile("s_waitcnt vmcnt(0)" ::: "memory");
    __syncthreads();
    if (threadIdx.x == 0) {
        unsigned* bar = b.bar;
        __builtin_amdgcn_s_waitcnt(0);
        unsigned nloc = b.st[0], nx = b.st[1];
        if (nloc == 0u) { xcd_barrier_complete(bar, b.x, nloc, nx); b.st[0] = nloc; b.st[1] = nx; }
        const unsigned old = xb_add(&bar[XB_XSUB(b.x)], 1u);
        const unsigned gen = old / nloc;
        if (old + 1u == (gen + 1u) * nloc) {
            __builtin_amdgcn_fence(__ATOMIC_RELEASE, "agent");
            asm volatile("s_waitcnt vmcnt(0)" ::: "memory");
            const unsigned og = xb_add(&bar[XB_TOP], 1u);
            const unsigned tg = og / nx;
            if (og + 1u == (tg + 1u) * nx) xb_add(&bar[XB_TOPGEN], 1u);
            else XB_SPIN(xb_ld(&bar[XB_TOPGEN]) == tg, bar);
            __builtin_amdgcn_fence(__ATOMIC_ACQUIRE, "agent");
            xb_add(&bar[XB_XGEN(b.x)], 1u);
            asm volatile("s_waitcnt vmcnt(0)" ::: "memory");
        } else {
            XB_SPIN(xb_ld(&bar[XB_XGEN(b.x)]) == gen, bar);
            __builtin_amdgcn_fence(__ATOMIC_ACQUIRE, "agent");
            asm volatile("s_waitcnt vmcnt(0)" ::: "memory");
        }
    }
    __syncthreads();
}

struct Unit { int pm, pn; };
struct MoeTab { const LAS int* tb; const LAS int* tf; const LAS int* cnt; int T;
    __device__ __forceinline__ int bucket(int pm) const { return __builtin_amdgcn_readfirstlane(tb[pm]); }
    __device__ __forceinline__ int first(int pm) const { return __builtin_amdgcn_readfirstlane(tf[pm]); }
    __device__ __forceinline__ int count(int b) const { return __builtin_amdgcn_readfirstlane(cnt[b]); }
};

struct ProbDense {
    static constexpr bool GATHER = false;
    const bf16_t* A; const bf16_t* Bt; int lda, ldb, K, nM, nN;
    __device__ __forceinline__ int n_m() const { return nM; }
    __device__ __forceinline__ int n_n() const { return nN; }
    __device__ __forceinline__ unsigned a_off(int pm, int R) const { return (unsigned)(pm * 256 + R) * (unsigned)(lda * 2); }
    __device__ __forceinline__ const char* b_base(int pm, int pn) const { return (const char*)Bt + (size_t)pn * 256 * ldb * 2; }
};
struct ProbGU {
    static constexpr bool GATHER = true;
    const bf16_t* A; const bf16_t* GU; const int* toklist; MoeTab tab; int lda, ldb, K;
    __device__ __forceinline__ int n_m() const { return tab.T; }
    __device__ __forceinline__ int n_n() const { return 4; }
    __device__ __forceinline__ unsigned a_off(int pm, int R) const {
        const int b = tab.bucket(pm), idx = tab.first(pm) * 256 + R; const int tok = idx < tab.count(b) ? toklist[b * NTOK + idx] : 0;
        return (unsigned)tok * 2048u; }
    __device__ __forceinline__ const char* b_base(int pm, int pn) const {
        const int b = tab.bucket(pm), g = b / 6, p = b % 6, e = g * 4 + ((pn >> 1) ? pair_hi(p) : pair_lo(p));
        return (const char*)GU + ((size_t)e * 512 + (size_t)(pn & 1) * 256) * 2048; }
};
struct ProbDN {
    static constexpr bool GATHER = false;
    const bf16_t* A; const bf16_t* DN; MoeTab tab; int lda, ldb, K;
    __device__ __forceinline__ int n_m() const { return tab.T; }
    __device__ __forceinline__ int n_n() const { return 4; }
    __device__ __forceinline__ unsigned a_off(int pm, int R) const { return (unsigned)(pm * 256 + R) * 1024u; }
    __device__ __forceinline__ const char* b_base(int pm, int pn) const { const int b = tab.bucket(pm); return (const char*)DN + ((size_t)b * 1024 + (size_t)pn * 256) * 1024; }
};

__device__ __forceinline__ void st_bf4(bf16_t* p, f32x4 v) { u32x2 w; w.x = pk2(v[0], v[1]); w.y = pk2(v[2], v[3]); *(u32x2*)p = w; }
struct EpiIn {
    bf16_t* base;
    struct Row { bf16_t* d; };
    __device__ __forceinline__ Row row(int pm, int pn, int r) const { Row c; c.d = base + (size_t)(pn >> 1) * NTOK * 512 + (size_t)(pm * 256 + r) * 512 + (pn & 1) * 256; return c; }
    __device__ __forceinline__ void elem(const Row& c, int cq, f32x4 v0, f32x4 v1) const { st_bf4(c.d + cq, v0); st_bf4(c.d + 128 + cq, v1); }
};
struct EpiRes {
    const float* res; float* out;
    struct Row { const float* r; float* o; };
    __device__ __forceinline__ Row row(int pm, int pn, int r) const { const size_t o = (size_t)(pm * 256 + r) * 1024 + pn * 256; Row c; c.r = res + o; c.o = out + o; return c; }
    __device__ __forceinline__ void elem(const Row& c, int cq, f32x4 v0, f32x4 v1) const {
        *(f32x4*)(c.o + cq) = *(const f32x4*)(c.r + cq) + v0; *(f32x4*)(c.o + cq + 128) = *(const f32x4*)(c.r + cq + 128) + v1; }
};
struct EpiGU {
    bf16_t* act; const f32x2* cwl; MoeTab tab;
    struct Row { bf16_t* d; float cw; };
    __device__ __forceinline__ Row row(int pm, int pn, int r) const {
        const int b = tab.bucket(pm), idx = tab.first(pm) * 256 + r; Row c; c.cw = 0.f;
        if (idx < tab.count(b)) { const f32x2 w = cwl[b * NTOK + idx]; c.cw = (pn >> 1) ? w.y : w.x; }
        c.d = act + (size_t)(pm * 256 + r) * 512 + (pn >> 1) * 256 + (pn & 1) * 128; return c; }
    __device__ __forceinline__ void elem(const Row& c, int cq, f32x4 v0, f32x4 v1) const {
        f32x4 o;
#pragma unroll
        for (int j = 0; j < 4; ++j) o[j] = silu1(v0[j]) * v1[j] * c.cw;
        st_bf4(c.d + cq, o); }
};
struct EpiDN {
    float* h; const int* toklist; MoeTab tab;
    struct Row { float* p; };
    __device__ __forceinline__ Row row(int pm, int pn, int r) const {
        const int b = tab.bucket(pm), idx = tab.first(pm) * 256 + r; Row c; c.p = nullptr;
        if (idx < tab.count(b)) { const int tok = toklist[b * NTOK + idx]; c.p = h + (size_t)tok * 1024 + pn * 256; } return c; }
    __device__ __forceinline__ void elem(const Row& c, int cq, f32x4 v0, f32x4 v1) const {
        if (c.p) { float* p = c.p + cq; *(f32x4*)p = *(const f32x4*)p + v0; *(f32x4*)(p + 128) = *(const f32x4*)(p + 128) + v1; } }
};
struct EpiSin {
    bf16_t* U; bf16_t* V1; const float* bias;
    struct Row { bf16_t* d; const float* b; };
    __device__ __forceinline__ Row row(int pm, int pn, int r) const { Row c; c.d = (pn < 4 ? U + pn * 256 : V1 + (pn - 4) * 256) + (size_t)(pm * 256 + r) * 1024; c.b = bias + pn * 256; return c; }
    __device__ __forceinline__ void elem(const Row& c, int cq, f32x4 v0, f32x4 v1) const {
        const f32x4 b0 = *(const f32x4*)(c.b + cq), b1 = *(const f32x4*)(c.b + cq + 128);
        st_bf4(c.d + cq, gelu4(v0 + b0)); st_bf4(c.d + cq + 128, gelu4(v1 + b1)); }
};

template <class Prob, class Epi>
__device__ __forceinline__ void gemm_naive(LAS unsigned char* lds, const Prob& P, const Epi& E) {
    const int tid = threadIdx.x;
    LAS float* As = (LAS float*)lds;
    LAS float* Bs = (LAS float*)(lds + 8192);
    const int nsub = P.n_m() * P.n_n() * 4;
    const int cq = (tid & 31) * 4, rg = tid >> 5;
    for (int su = blockIdx.x; su < nsub; su += gridDim.x) {
        const int un = su >> 2, sb = su & 3, pm = un / P.n_n(), pn = un % P.n_n();
        f32x4 acc0[4], acc1[4];
#pragma unroll
        for (int i = 0; i < 4; ++i) { acc0[i] = (f32x4){0.f, 0.f, 0.f, 0.f}; acc1[i] = acc0[i]; }
        const char* Bb = P.b_base(pm, pn);
        const char* Ab = (const char*)P.A;
        unsigned aoff = 0; if (tid < 256) aoff = P.a_off(pm, sb * 64 + (tid >> 2)) + (tid & 3) * 16;
        for (int k0 = 0; k0 < P.K; k0 += 32) {
            __syncthreads();
            if (tid < 256) { const u32x4 w = *(const u32x4*)(Ab + aoff + k0 * 2); const int row = tid >> 2, ch = tid & 3;
#pragma unroll
                for (int j = 0; j < 4; ++j) { As[(ch * 8 + 2 * j) * 64 + row] = bflo(w[j]); As[(ch * 8 + 2 * j + 1) * 64 + row] = bfhi(w[j]); } }
#pragma unroll
            for (int i = 0; i < 2; ++i) { const int idx = tid + 512 * i, c = idx >> 2, ch = idx & 3;
                const u32x4 w = *(const u32x4*)(Bb + ((size_t)c * P.ldb + k0 + ch * 8) * 2);
#pragma unroll
                for (int j = 0; j < 4; ++j) { Bs[(ch * 8 + 2 * j) * 256 + c] = bflo(w[j]); Bs[(ch * 8 + 2 * j + 1) * 256 + c] = bfhi(w[j]); } }
            __syncthreads();
#pragma unroll 4
            for (int kk = 0; kk < 32; ++kk) {
                const f32x4 b0 = *(const LAS f32x4*)(Bs + kk * 256 + cq), b1 = *(const LAS f32x4*)(Bs + kk * 256 + 128 + cq);
#pragma unroll
                for (int i = 0; i < 4; ++i) { const float a = As[kk * 64 + rg + 16 * i]; acc0[i] += b0 * a; acc1[i] += b1 * a; }
            }
        }
#pragma unroll
        for (int i = 0; i < 4; ++i) { const typename Epi::Row rc = E.row(pm, pn, sb * 64 + rg + 16 * i); E.elem(rc, cq, acc0[i], acc1[i]); }
    }
    __syncthreads();
}

namespace pg8 {
constexpr int BM = 256, BK = 64, HALF = 128, HTB = HALF * BK * 2, STAGE_BYTES = 8 * HTB, NXCD = 8, WGM = 8;
__host__ __device__ __forceinline__ int lds_byte(int r, int c) { const int st = (r >> 4) * 2 + (c >> 5), rr = r & 15, cc = c & 31, ob = rr * 64 + cc * 2; return st * 1024 + (ob ^ (((ob >> 9) & 1) << 5)); }
__host__ __device__ __forceinline__ void stage_rc(int b, int& R, int& C) { const int st = b / 1024, sb = b % 1024, swz = sb ^ (((sb >> 9) & 1) << 5); R = (st >> 1) * 16 + swz / 64; C = (st & 1) * 32 + (swz % 64) / 2; }
struct StaticOrder {
    int nM, nN, nwg, G, c;
    __device__ __forceinline__ void init(int nM_, int nN_, int G_, int c_) { nM = nM_; nN = nN_; nwg = nM * nN; G = G_; c = c_; }
    __device__ __forceinline__ bool next(int i, Unit& u) const {
        const long L = (long)i * G + c; if (L >= nwg) return false;
        int wgid = (int)L; { const int q = nwg / NXCD, r = nwg % NXCD, xcd = wgid % NXCD, off = wgid / NXCD; wgid = (xcd < r ? xcd * (q + 1) : r * (q + 1) + (xcd - r) * q) + off; }
        const int nig = WGM * nN, gid = wgid / nig, fm = gid * WGM, gsz = (nM - fm) < WGM ? (nM - fm) : WGM;
        u.pm = fm + ((wgid % nig) % gsz); u.pn = (wgid % nig) / gsz; return true;
    }
};

template <class Prob, class Epi>
__device__ __forceinline__ void gemm_phase(LAS unsigned char* lds, const Prob& P, const Epi& E) {
    const int tid = threadIdx.x, wid = __builtin_amdgcn_readfirstlane(tid >> 6), lane = tid & 63, wr = wid >> 2, wc = wid & 3, fr = lane & 15, fq = lane >> 4;
    const int K = P.K, nt = K / BK;
    StaticOrder S; S.init(P.n_m(), P.n_n(), (int)gridDim.x, (int)blockIdx.x);
    unsigned voffB[2];
#pragma unroll
    for (int i = 0; i < 2; ++i) { int R, C; stage_rc(tid * 16 + i * 8192, R, C); voffB[i] = (unsigned)(R * P.ldb + C) * 2u; }
    const size_t kstep = (size_t)(BK * 2);
    const size_t hstepB = (size_t)HALF * P.ldb * 2;
    const unsigned ldsw = (unsigned)wid * 1024u;
    const int aoff = lds_byte(wr * 64 + fr, fq * 8), boff = lds_byte(wc * 32 + fr, fq * 8);
    const char* Abase = (const char*)P.A;
#define PG8_SA(b, h) (((b) * 2 + (h)) * HTB)
#define PG8_SB(b, h) ((4 + (b) * 2 + (h)) * HTB)
#define PG8_STAGEB(bufoff, gbase) do { _Pragma("unroll") for (int _i = 0; _i < 2; ++_i) \
        __builtin_amdgcn_global_load_lds((const unsigned*)((const char*)(gbase) + voffB[_i]), (LAS unsigned*)(lds + (bufoff) + ldsw + _i * 8192), 16, 0, 0); } while (0)
#define PG8_STAGEA(bufoff, va, h, kb) do { _Pragma("unroll") for (int _i = 0; _i < 2; ++_i) \
        __builtin_amdgcn_global_load_lds((const unsigned*)(Abase + (size_t)(va)[h][_i] + (kb)), (LAS unsigned*)(lds + (bufoff) + ldsw + _i * 8192), 16, 0, 0); } while (0)
#define PG8_LDA(dst, b, h) do { _Pragma("unroll") for (int m = 0; m < 4; ++m) _Pragma("unroll") for (int k = 0; k < 2; ++k) dst[m][k] = *(const LAS bf16x8*)(lds + PG8_SA(b, h) + aoff + m * 2048 + k * 1024); } while (0)
#define PG8_LDB(dst, b, h) do { _Pragma("unroll") for (int n = 0; n < 2; ++n) _Pragma("unroll") for (int k = 0; k < 2; ++k) dst[n][k] = *(const LAS bf16x8*)(lds + PG8_SB(b, h) + boff + n * 2048 + k * 1024); } while (0)
#define PG8_MMA(ai, bj, At, Bt) do { __builtin_amdgcn_s_setprio(1); _Pragma("unroll") for (int m = 0; m < 4; ++m) _Pragma("unroll") for (int n = 0; n < 2; ++n) _Pragma("unroll") for (int k = 0; k < 2; ++k) \
        acc[ai][bj][m][n] = __builtin_amdgcn_mfma_f32_16x16x32_bf16(Bt[n][k], At[m][k], acc[ai][bj][m][n], 0, 0, 0); __builtin_amdgcn_s_setprio(0); } while (0)
#define PG8_WAIT_V(n) asm volatile("s_waitcnt vmcnt(" #n ")" ::: "memory")
#define PG8_WAIT_L(n) asm volatile("s_waitcnt lgkmcnt(" #n ")" ::: "memory")
#define PG8_BAR __builtin_amdgcn_s_barrier()
#define PG8_SCHED __builtin_amdgcn_sched_barrier(0)
#define PG8_AOFFS(va, pm_) do { _Pragma("unroll") for (int _i = 0; _i < 2; ++_i) { int R_, C_; stage_rc(tid * 16 + _i * 8192, R_, C_); \
        (va)[0][_i] = P.a_off((pm_), R_) + (unsigned)C_ * 2u; (va)[1][_i] = P.a_off((pm_), HALF + R_) + (unsigned)C_ * 2u; } } while (0)
#define PG8_KBODY(VA2, B2, K1, K2, HOOK) do { \
            const char* b2_ = (B2); const char* b3_ = b2_ + kstep; const size_t k1_ = (K1), k2_ = (K2), k3_ = k2_ + kstep; \
            PG8_LDB(B0, 0, 0); PG8_LDB(B1, 0, 1); PG8_SCHED; PG8_LDA(At, 0, 0); PG8_STAGEA(PG8_SA(1, 1), vaC, 1, k1_); HOOK; \
            PG8_WAIT_V(8); PG8_WAIT_L(0); PG8_BAR; PG8_MMA(0, 0, At, B0); PG8_MMA(0, 1, At, B1); PG8_BAR; PG8_SCHED; \
            PG8_LDA(At, 0, 1); PG8_STAGEB(PG8_SB(0, 0), b2_); PG8_STAGEB(PG8_SB(0, 1), b2_ + hstepB); PG8_STAGEA(PG8_SA(0, 0), VA2, 0, k2_); \
            PG8_WAIT_V(8); PG8_WAIT_L(0); PG8_BAR; PG8_MMA(1, 0, At, B0); PG8_MMA(1, 1, At, B1); PG8_BAR; PG8_SCHED; \
            PG8_LDB(B0, 1, 0); PG8_LDB(B1, 1, 1); PG8_SCHED; PG8_LDA(At, 1, 0); PG8_STAGEA(PG8_SA(0, 1), VA2, 1, k2_); \
            PG8_WAIT_V(8); PG8_WAIT_L(0); PG8_BAR; PG8_MMA(0, 0, At, B0); PG8_MMA(0, 1, At, B1); PG8_BAR; PG8_SCHED; \
            PG8_LDA(At, 1, 1); PG8_STAGEB(PG8_SB(1, 0), b3_); PG8_STAGEB(PG8_SB(1, 1), b3_ + hstepB); PG8_STAGEA(PG8_SA(1, 0), VA2, 0, k3_); \
            PG8_WAIT_V(8); PG8_WAIT_L(0); PG8_BAR; PG8_MMA(1, 0, At, B0); PG8_MMA(1, 1, At, B1); PG8_BAR; PG8_SCHED; } while (0)
    Unit cur, nxt; int ui = 0;
    if (!S.next(0, cur)) return;
    f32x4 acc[2][2][4][2];
#pragma unroll
    for (int a = 0; a < 2; ++a)
#pragma unroll
        for (int b = 0; b < 2; ++b)
#pragma unroll
            for (int m = 0; m < 4; ++m)
#pragma unroll
                for (int n = 0; n < 2; ++n) acc[a][b][m][n] = (f32x4){0.f, 0.f, 0.f, 0.f};
    bf16x8 At[4][2], B0[2][2], B1[2][2];
    constexpr bool GATHER = Prob::GATHER;
    unsigned vaC[2][2], vaN[2][2];
    LAS u32x4* stash = (LAS u32x4*)(lds + STASH_OFF) + tid;
    PG8_AOFFS(vaC, cur.pm);
    const char* cB = P.b_base(cur.pm, cur.pn);
    PG8_STAGEB(PG8_SB(0, 0), cB); PG8_STAGEB(PG8_SB(0, 1), cB + hstepB); PG8_STAGEA(PG8_SA(0, 0), vaC, 0, 0); PG8_STAGEA(PG8_SA(0, 1), vaC, 1, 0);
    if (wr == 1) PG8_BAR;
    PG8_WAIT_V(2); PG8_BAR;
    PG8_STAGEB(PG8_SB(1, 0), cB + kstep); PG8_STAGEA(PG8_SA(1, 0), vaC, 0, kstep); PG8_STAGEB(PG8_SB(1, 1), cB + hstepB + kstep);
    PG8_WAIT_V(6); PG8_BAR;
    for (;;) {
        const bool has_next = S.next(ui + 1, nxt);
        const char* nB = cB;
        if constexpr (GATHER) {
            if (has_next) { nB = P.b_base(nxt.pm, nxt.pn); unsigned tmp[2][2]; PG8_AOFFS(tmp, nxt.pm); *stash = (u32x4){tmp[0][0], tmp[0][1], tmp[1][0], tmp[1][1]}; }
            for (int t = 0; t < nt; t += 2) {
                const bool last = (t == nt - 2);
                const size_t k2 = last ? 0 : (size_t)(t + 2) * kstep;
                PG8_KBODY(vaC, (last ? nB : cB) + k2, (size_t)(t + 1) * kstep, k2,
                          if (last && has_next) { const u32x4 w_ = *stash; vaC[0][0] = w_.x; vaC[0][1] = w_.y; vaC[1][0] = w_.z; vaC[1][1] = w_.w; });
            }
        } else {
            if (has_next) { nB = P.b_base(nxt.pm, nxt.pn); PG8_AOFFS(vaN, nxt.pm); }
            else {
#pragma unroll
                for (int h = 0; h < 2; ++h)
#pragma unroll
                    for (int i = 0; i < 2; ++i) vaN[h][i] = vaC[h][i];
            }
            for (int t = 0; t < nt; t += 2) {
                const bool last = (t == nt - 2);
                unsigned va2[2][2];
#pragma unroll
                for (int h = 0; h < 2; ++h)
#pragma unroll
                    for (int i = 0; i < 2; ++i) va2[h][i] = last ? vaN[h][i] : vaC[h][i];
                const size_t k2 = last ? 0 : (size_t)(t + 2) * kstep;
                PG8_KBODY(va2, (last ? nB : cB) + k2, (size_t)(t + 1) * kstep, k2, (void)0);
            }
        }
        if (wr == 0) PG8_BAR;
        {
#pragma unroll
            for (int ai = 0; ai < 2; ++ai)
#pragma unroll
                for (int m = 0; m < 4; ++m) {
                    const typename Epi::Row rc = E.row(cur.pm, cur.pn, ai * HALF + wr * 64 + m * 16 + fr);
#pragma unroll
                    for (int n = 0; n < 2; ++n) E.elem(rc, wc * 32 + n * 16 + 4 * fq, acc[ai][0][m][n], acc[ai][1][m][n]);
                    if (m & 1) asm volatile("" ::: "memory");
                }
        }
        if (!has_next) break;
#pragma unroll
        for (int a = 0; a < 2; ++a)
#pragma unroll
            for (int b = 0; b < 2; ++b)
#pragma unroll
                for (int m = 0; m < 4; ++m)
#pragma unroll
                    for (int n = 0; n < 2; ++n) acc[a][b][m][n] = (f32x4){0.f, 0.f, 0.f, 0.f};
        cur = nxt; cB = nB; ++ui;
        if constexpr (!GATHER) {
#pragma unroll
            for (int h = 0; h < 2; ++h)
#pragma unroll
                for (int i = 0; i < 2; ++i) vaC[h][i] = vaN[h][i];
        }
        if (wr == 1) PG8_BAR;
    }
    PG8_WAIT_V(0);
    PG8_BAR;
#undef PG8_SA
#undef PG8_SB
#undef PG8_STAGEA
#undef PG8_STAGEB
#undef PG8_LDA
#undef PG8_LDB
#undef PG8_MMA
#undef PG8_WAIT_V
#undef PG8_WAIT_L
#undef PG8_BAR
#undef PG8_SCHED
#undef PG8_AOFFS
#undef PG8_KBODY
}
}

template <class Prob, class Epi>
__device__ __forceinline__ void run_gemm(LAS unsigned char* lds, const Prob& P, const Epi& E) {
#if NAIVE_GEMM
    gemm_naive(lds, P, E);
#else
    pg8::gemm_phase(lds, P, E);
#endif
}

__device__ __forceinline__ void tr_item(const float* W, int ldw, int k0, int n0, bf16_t* dst, int ldd, int drow0, int dk0, const float* gain, float cs, LAS float* scr, int lane) {
#pragma unroll 8
    for (int i = 0; i < 32; ++i) { const int kk = 2 * i + (lane >> 5); float v = W[(size_t)(k0 + kk) * ldw + n0 + (lane & 31)]; if (gain) v *= gain[k0 + kk]; scr[kk * 33 + (lane & 31)] = v * cs; }
    LDS_WAIT(); asm volatile("" ::: "memory");
    const int c = lane & 7;
#pragma unroll
    for (int j = 0; j < 4; ++j) { const int n = (lane >> 3) + 8 * j; const LAS float* s = scr + (8 * c) * 33 + n;
        u32x4 o; o.x = pk2(s[0 * 33], s[1 * 33]); o.y = pk2(s[2 * 33], s[3 * 33]); o.z = pk2(s[4 * 33], s[5 * 33]); o.w = pk2(s[6 * 33], s[7 * 33]);
        *(u32x4*)(dst + (size_t)(drow0 + n) * ldd + dk0 + 8 * c) = o; }
    LDS_WAIT(); asm volatile("" ::: "memory");
}
__device__ __forceinline__ void fold_item(const float* Win, const float* pw, const float* pscale, const float* gain, bf16_t* BT, int ko, int nb, int lane) {
    const int n = nb * 64 + lane, g = nb >> 1, d = n & 127;
    const float* wrow = Win + (size_t)(ko * 8) * 2048 + g * 128;
    const float* pwc = pw + (size_t)g * 128 * 128 + d;
    float acc[8];
#pragma unroll
    for (int j = 0; j < 8; ++j) acc[j] = 0.f;
    for (int c = 0; c < 128; ++c) { const float w = pwc[c * 128];
#pragma unroll
        for (int j = 0; j < 8; ++j) acc[j] += wrow[j * 2048 + c] * w; }
    const float sc = pscale[n];
#pragma unroll
    for (int j = 0; j < 8; ++j) acc[j] *= sc * gain[ko * 8 + j];
    u32x4 o; o.x = pk2(acc[0], acc[1]); o.y = pk2(acc[2], acc[3]); o.z = pk2(acc[4], acc[5]); o.w = pk2(acc[6], acc[7]);
    *(u32x4*)(BT + (size_t)n * 1024 + ko * 8) = o;
}
__device__ __forceinline__ void rms_row_bf16(const float* xrow, bf16_t* orow, int lane) {
    const f32x4* xr = (const f32x4*)xrow + lane; f32x4 v[4]; float s = 0.f;
#pragma unroll
    for (int j = 0; j < 4; ++j) { v[j] = xr[64 * j]; s += (v[j].x * v[j].x + v[j].y * v[j].y) + (v[j].z * v[j].z + v[j].w * v[j].w); }
    const float r = 1.0f / sqrtf(wave_sum(s) * (1.0f / 1024.0f) + EPS);
    unsigned long long* o8 = (unsigned long long*)orow + lane;
#pragma unroll
    for (int j = 0; j < 4; ++j) o8[64 * j] = (unsigned long long)pk2(v[j].x * r, v[j].y * r) | ((unsigned long long)pk2(v[j].z * r, v[j].w * r) << 32);
}
__device__ __forceinline__ void ph_prep(KA a, LAS unsigned char* lds) {
    const int tid = threadIdx.x, lane = tid & 63, wave = __builtin_amdgcn_readfirstlane(tid >> 6);
    const int gw = blockIdx.x * 8 + wave, NGW = gridDim.x * 8;
    LAS float* scr = (LAS float*)(lds + wave * 16384);
    unsigned char* ws = a.ws();
    bf16_t* BT_IN = (bf16_t*)(ws + WS_BT_IN); bf16_t* BT_OUT = (bf16_t*)(ws + WS_BT_OUT); bf16_t* BT_SIN = (bf16_t*)(ws + WS_BT_SIN); bf16_t* BT_SOUT = (bf16_t*)(ws + WS_BT_SOUT);
    constexpr int N_FOLD = 1024, N_QKV = 768, N_OUT = 512, N_SIN = 1024, N_SOUT = 512, N_GU = 8192, N_DN = 12288;
    constexpr int NITEMS = N_FOLD + N_QKV + N_OUT + N_SIN + N_SOUT + N_GU + N_DN;
    for (int it = gw; it < NITEMS; it += NGW) {
        int r = it;
        if (r < N_FOLD) { fold_item(a.in(I_WIN), a.in(I_POOLW), a.in(I_POOLS), a.in(I_GMIX), BT_IN, r >> 3, r & 7, lane); continue; } r -= N_FOLD;
        if (r < N_QKV) { const int kb = r / 48, nb = r % 48, n0 = 512 + nb * 32; tr_item(a.in(I_WIN), 2048, kb * 64, n0, BT_IN, 1024, n0, kb * 64, a.in(I_GMIX), n0 < 1024 ? C2 : 1.0f, scr, lane); continue; } r -= N_QKV;
        if (r < N_OUT) { const int kb = r / 32, nb = r % 32; tr_item(a.in(I_WOUT), 1024, kb * 64, nb * 32, BT_OUT, 1024, nb * 32, kb * 64, nullptr, 1.0f, scr, lane); continue; } r -= N_OUT;
        if (r < N_SIN) { const int kb = r / 64, nb = r % 64; tr_item(a.in(I_SWIN), 2048, kb * 64, nb * 32, BT_SIN, 1024, nb * 32, kb * 64, a.in(I_GMIX) + 1024, 1.0f, scr, lane); continue; } r -= N_SIN;
        if (r < N_SOUT) { const int kb = r / 32, nb = r % 32; tr_item(a.in(I_SWOUT), 1024, kb * 64, nb * 32, BT_SOUT, 1024, nb * 32, kb * 64, nullptr, 1.0f, scr, lane); continue; } r -= N_SOUT;
        if (r < N_GU) { const int l = r / 4096, r1 = r % 4096, isup = r1 / 2048, r2 = r1 % 2048, e = r2 / 128, r3 = r2 % 128, kb = r3 / 8, nb = r3 % 8, n0 = nb * 32;
            const float* W = a.in(isup ? I_WU : I_WG) + (size_t)(l * 16 + e) * 1024 * 256;
            bf16_t* dst = (bf16_t*)(ws + WS_GU + (size_t)l * 16 * MiB) + (size_t)e * 512 * 1024;
            tr_item(W, 256, kb * 64, n0, dst, 1024, (n0 >> 7) * 256 + (n0 & 127) + isup * 128, kb * 64, a.in(I_GFFN) + l * 1024, 1.0f, scr, lane); continue; } r -= N_GU;
        { const int l = r / 6144, r1 = r % 6144, b = r1 / 256, r2 = r1 % 256, s = r2 / 128, r3 = r2 % 128, kb = r3 / 32, nb = r3 % 32;
            const int g = b / 6, p = b % 6, e = g * 4 + (s ? pair_hi(p) : pair_lo(p));
            const float* W = a.in(I_WD) + (size_t)(l * 16 + e) * 256 * 1024;
            bf16_t* dst = (bf16_t*)(ws + WS_DN + (size_t)l * 24 * MiB) + (size_t)b * 1024 * 512;
            tr_item(W, 1024, kb * 64, nb * 32, dst, 512, nb * 32, s * 256 + kb * 64, nullptr, 1.0f, scr, lane); }
    }
    { bf16_t* WSB = (bf16_t*)(ws + WS_WS); const float* w = a.in(I_SWS);
      for (int i = blockIdx.x * 512 + tid; i < 8 * 128 * 128; i += gridDim.x * 512) { const int t = (i >> 7) & 127, s = i & 127; WSB[i] = (bf16_t)f2bf(s <= t ? w[i] : 0.f); } }
    { bf16_t* XN = (bf16_t*)(ws + WS_XN); const float* x = a.in(I_X);
      for (int m = gw; m < NTOK; m += NGW) rms_row_bf16(x + (size_t)m * 1024, XN + (size_t)m * 1024, lane); }
}

__device__ __forceinline__ void ph_pool(KA a) {
    unsigned char* ws = a.ws();
    const bf16_t* P = (const bf16_t*)(ws + WS_P); bf16_t* MIX = (bf16_t*)(ws + WS_MIX);
    const int nthr = gridDim.x * 512;
    for (int i = blockIdx.x * 512 + threadIdx.x; i < NTOK * 64; i += nthr) {
        const int tok = i >> 6, n = (i & 63) * 8, w = 2 << (n >> 7), tp = tok & (SEQ - 1);
        const int start = (tp + 1 - w) > 0 ? (tp + 1 - w) : 0, cnt = tp + 1 - start;
        float s[8];
#pragma unroll
        for (int j = 0; j < 8; ++j) s[j] = 0.f;
        u32x4 self = (u32x4){0u, 0u, 0u, 0u};
        for (int q = 0; q < cnt; ++q) { const u32x4 v = *(const u32x4*)(P + (size_t)(tok - q) * 512 + n); if (q == 0) self = v;
#pragma unroll
            for (int j = 0; j < 4; ++j) { s[2 * j] += bflo(v[j]); s[2 * j + 1] += bfhi(v[j]); } }
        const float inv = 1.0f / (float)cnt; u32x4 o;
#pragma unroll
        for (int j = 0; j < 4; ++j) o[j] = pk2(s[2 * j] * inv - bflo(self[j]), s[2 * j + 1] * inv - bfhi(self[j]));
        *(u32x4*)(MIX + (size_t)tok * 1024 + n) = o;
    }
}
__device__ __forceinline__ void ph_attn_naive(KA a) {
    unsigned char* ws = a.ws();
    const bf16_t* Q = (const bf16_t*)(ws + WS_Q); const bf16_t* K = (const bf16_t*)(ws + WS_K); const bf16_t* V = (const bf16_t*)(ws + WS_V);
    bf16_t* MIX = (bf16_t*)(ws + WS_MIX); const float* relb = a.in(I_RELB);
    const int lane = threadIdx.x & 63, wave = __builtin_amdgcn_readfirstlane(threadIdx.x >> 6);
    const int gw = blockIdx.x * 8 + wave, NGW = gridDim.x * 8;
    for (int task = gw; task < NBATCH * 8 * SEQ; task += NGW) {
        const int s = task & (SEQ - 1), h = (task >> 12) & 7, b = task >> 15, c = s >> 6;
        const bf16_t* qrow = Q + (size_t)(b * SEQ + s) * 512 + h * 64;
        float q[64];
#pragma unroll
        for (int i = 0; i < 8; ++i) { const u32x4 w = *(const u32x4*)(qrow + i * 8);
#pragma unroll
            for (int j = 0; j < 4; ++j) { q[i * 8 + 2 * j] = bflo(w[j]); q[i * 8 + 2 * j + 1] = bfhi(w[j]); } }
        float mx = -1e30f, l = 0.f, o = 0.f;
#pragma unroll 1
        for (int i = 0; i < 9; ++i) {
            const int kb = c * 64 - 512 + 64 * i;
            if (kb < 0) continue;
            const int kp = kb + lane;
            const bf16_t* krow = K + (size_t)(b * SEQ + kp) * 512 + h * 64; float d = 0.f;
#pragma unroll
            for (int ii = 0; ii < 8; ++ii) { const u32x4 w = *(const u32x4*)(krow + ii * 8);
#pragma unroll
                for (int j = 0; j < 4; ++j) { d += q[ii * 8 + 2 * j] * bflo(w[j]); d += q[ii * 8 + 2 * j + 1] * bfhi(w[j]); } }
            int rel = kp - s; rel = rel < -128 ? -128 : (rel > 128 ? 128 : rel);
            const float sc = d + relb[h * 257 + rel + 128] * LOG2E;
            const float mn = fmaxf(mx, wave_max(sc)), alpha = exp2f(mx - mn), p = exp2f(sc - mn);
            mx = mn; l = l * alpha + wave_sum(p); o *= alpha;
            const bf16_t* vb = V + (size_t)(b * SEQ + kb) * 512 + h * 64 + lane;
            for (int l2 = 0; l2 < 64; ++l2) { const float pj = __builtin_bit_cast(float, __builtin_amdgcn_readlane(__builtin_bit_cast(int, p), l2)); o += pj * bf2f(vb[(size_t)l2 * 512]); }
        }
        MIX[(size_t)(b * SEQ + s) * 1024 + 512 + h * 64 + lane] = (bf16_t)f2bf(o / l);
    }
}

__device__ __forceinline__ void ph_route(KA a, LAS unsigned char* lds, int layer) {
    const int tid = threadIdx.x, lane = tid & 63, wave = __builtin_amdgcn_readfirstlane(tid >> 6);
    LAS float* Wr = (LAS float*)lds;
    LAS int* s_bucket = (LAS int*)(lds + 81920); LAS float* s_cw = (LAS float*)(lds + 81920 + 512); LAS int* s_base = (LAS int*)(lds + 81920 + 512 + 1024);
    const float* gffn = a.in(I_GFFN) + layer * 1024;
    const float* wg = a.in(I_WGR) + (size_t)layer * 1024 * 4; const float* we = a.in(I_WER) + (size_t)layer * 4 * 1024 * 4;
    const float* bg = a.in(I_BGR) + layer * 4; const float* be = a.in(I_BER) + layer * 16;
    for (int i = tid; i < 4096; i += 512) { const int k = i >> 2, o = i & 3; Wr[o * 1024 + k] = wg[i] * gffn[k]; }
    for (int i = tid; i < 16384; i += 512) { const int g = i >> 12, k = (i >> 2) & 1023, o = i & 3; Wr[(4 + g * 4 + o) * 1024 + k] = we[i] * gffn[k]; }
    __syncthreads();
    unsigned char* ws = a.ws();
    const float* H = a.out(); bf16_t* XN = (bf16_t*)(ws + WS_XN);
    int* toklist = (int*)(ws + WS_TOK); f32x2* cwl = (f32x2*)(ws + WS_CW);
    unsigned* counts = (unsigned*)(ws + WS_CTL) + CW_CNT + 64 * layer;
    for (int tg = blockIdx.x; tg < NTOK / 128; tg += gridDim.x) {
        for (int ti = 0; ti < 16; ++ti) {
            const int lt = wave * 16 + ti, tok = tg * 128 + lt;
            const f32x4* xr = (const f32x4*)(H + (size_t)tok * 1024) + lane; f32x4 v[4]; float ss = 0.f;
#pragma unroll
            for (int j = 0; j < 4; ++j) { v[j] = xr[64 * j]; ss += (v[j].x * v[j].x + v[j].y * v[j].y) + (v[j].z * v[j].z + v[j].w * v[j].w); }
            float gl[4];
#pragma unroll
            for (int o = 0; o < 4; ++o) { float d = 0.f;
#pragma unroll
                for (int j = 0; j < 4; ++j) { const f32x4 w = *(const LAS f32x4*)(Wr + o * 1024 + 256 * j + 4 * lane); d += (v[j].x * w.x + v[j].y * w.y) + (v[j].z * w.z + v[j].w * w.w); }
                gl[o] = wave_sum(d); }
            const float r = 1.0f / sqrtf(wave_sum(ss) * (1.0f / 1024.0f) + EPS);
#pragma unroll
            for (int o = 0; o < 4; ++o) gl[o] = gl[o] * r + bg[o];
            int g = 0; float gm = gl[0];
#pragma unroll
            for (int o = 1; o < 4; ++o) if (gl[o] > gm) { gm = gl[o]; g = o; }
            float gs = 0.f;
#pragma unroll
            for (int o = 0; o < 4; ++o) gs += __expf(gl[o] - gm);
            const float gw_ = 1.0f / gs;
            g = __builtin_amdgcn_readfirstlane(g);
            float el[4];
#pragma unroll
            for (int o = 0; o < 4; ++o) { float d = 0.f;
#pragma unroll
                for (int j = 0; j < 4; ++j) { const f32x4 w = *(const LAS f32x4*)(Wr + (4 + g * 4 + o) * 1024 + 256 * j + 4 * lane); d += (v[j].x * w.x + v[j].y * w.y) + (v[j].z * w.z + v[j].w * w.w); }
                el[o] = wave_sum(d) * r + be[g * 4 + o]; }
            int e1 = 0; float m1 = el[0];
#pragma unroll
            for (int o = 1; o < 4; ++o) if (el[o] > m1) { m1 = el[o]; e1 = o; }
            int e2 = -1; float m2 = -3.0e38f;
#pragma unroll
            for (int o = 0; o < 4; ++o) if (o != e1 && el[o] > m2) { m2 = el[o]; e2 = o; }
            const float w2 = 1.0f / (1.0f + __expf(m1 - m2)), w1 = 1.0f - w2;
            const int lo = e1 < e2 ? e1 : e2, hi = e1 < e2 ? e2 : e1;
            const float cwlo = gw_ * (e1 < e2 ? w1 : w2), cwhi = gw_ * (e1 < e2 ? w2 : w1);
            const int pidx = lo == 0 ? hi - 1 : (lo == 1 ? hi + 1 : 5);
            if (lane == 0) { s_bucket[lt] = g * 6 + pidx; s_cw[lt * 2] = cwlo; s_cw[lt * 2 + 1] = cwhi; }
            unsigned long long* o8 = (unsigned long long*)(XN + (size_t)tok * 1024) + lane;
#pragma unroll
            for (int j = 0; j < 4; ++j) o8[64 * j] = (unsigned long long)pk2(v[j].x * r, v[j].y * r) | ((unsigned long long)pk2(v[j].z * r, v[j].w * r) << 32);
        }
        __syncthreads();
        if (tid < NBUCKET) { int c = 0; for (int i = 0; i < 128; ++i) c += (s_bucket[i] == tid) ? 1 : 0;
            s_base[tid] = c ? (int)__hip_atomic_fetch_add(counts + tid, (unsigned)c, RLX_AGENT) : 0; }
        __syncthreads();
        if (tid < 128) { const int b = s_bucket[tid]; int rank = 0; for (int i = 0; i < tid; ++i) rank += (s_bucket[i] == b) ? 1 : 0;
            const int pos = s_base[b] + rank; toklist[b * NTOK + pos] = tg * 128 + tid; cwl[b * NTOK + pos] = (f32x2){s_cw[tid * 2], s_cw[tid * 2 + 1]}; }
        __syncthreads();
    }
}
__device__ __forceinline__ MoeTab moe_table(KA a, LAS unsigned char* lds, int layer) {
    LAS int* tb = (LAS int*)(lds + TAB_OFF); LAS int* tf = tb + 160; LAS int* cnt = tf + 160; LAS int* tt = cnt + 24;
    __syncthreads();
    if (threadIdx.x == 0) { unsigned* counts = (unsigned*)(a.ws() + WS_CTL) + CW_CNT + 64 * layer; int t = 0;
        for (int b = 0; b < NBUCKET; ++b) { const int c = (int)__hip_atomic_load(counts + b, RLX_AGENT); cnt[b] = c; const int n = (c + 255) >> 8;
            for (int i = 0; i < n; ++i) { tb[t] = b; tf[t] = i; ++t; } }
        tt[0] = t; }
    __syncthreads();
    MoeTab m; m.tb = tb; m.tf = tf; m.cnt = cnt; m.T = __builtin_amdgcn_readfirstlane(tt[0]); return m;
}

__device__ __forceinline__ void ph_sgu_naive(KA a, LAS unsigned char* lds) {
    unsigned char* ws = a.ws();
    const bf16_t* U = (const bf16_t*)(ws + WS_U); const bf16_t* V1 = (const bf16_t*)(ws + WS_V1); const bf16_t* WSB = (const bf16_t*)(ws + WS_WS);
    bf16_t* MIX = (bf16_t*)(ws + WS_MIX); const float* slng = a.in(I_SLNG); const float* slnb = a.in(I_SLNB); const float* sbs = a.in(I_SBS);
    const int tid = threadIdx.x, lane = tid & 63, wave = __builtin_amdgcn_readfirstlane(tid >> 6);
    LAS float* mu = (LAS float*)lds; LAS float* rs = mu + 128;
    for (int un = blockIdx.x; un < NBATCH * 32 * 8; un += gridDim.x) {
        const int h = un & 7, bc = un >> 3, row0 = bc * 128;
        __syncthreads();
        for (int i = 0; i < 16; ++i) { const int rr = wave * 16 + i; const u32x4* vr = (const u32x4*)(V1 + (size_t)(row0 + rr) * 1024) + lane * 2; float s = 0.f, q = 0.f;
#pragma unroll
            for (int c = 0; c < 2; ++c) { const u32x4 w = vr[c];
#pragma unroll
                for (int j = 0; j < 4; ++j) { const float x0 = bflo(w[j]), x1 = bfhi(w[j]); s += x0 + x1; q += x0 * x0 + x1 * x1; } }
            s = wave_sum(s); q = wave_sum(q); const float mean = s * (1.0f / 1024.0f), var = q * (1.0f / 1024.0f) - mean * mean;
            if (lane == 0) { mu[rr] = mean; rs[rr] = 1.0f / sqrtf(var + EPS); } }
        __syncthreads();
        const int c = tid & 127, col = h * 128 + c; const float lg = slng[col], lb = slnb[col];
        for (int tt = tid >> 7; tt < 128; tt += 4) { float acc = 0.f;
            for (int s = 0; s <= tt; ++s) { const float vv = bf2f(V1[(size_t)(row0 + s) * 1024 + col]); const float vln = (vv - mu[s]) * rs[s] * lg + lb;
                acc += bf2f(WSB[(h * 128 + tt) * 128 + s]) * vln; }
            const float mixed = acc + sbs[h * 128 + tt]; const float u = bf2f(U[(size_t)(row0 + tt) * 1024 + col]);
            MIX[(size_t)(row0 + tt) * 1024 + col] = (bf16_t)f2bf(u * mixed); }
    }
    __syncthreads();
}

__device__ __forceinline__ void ph_norm_xn(KA a) {
    const int lane = threadIdx.x & 63, wave = __builtin_amdgcn_readfirstlane(threadIdx.x >> 6), gw = blockIdx.x * 8 + wave, NGW = gridDim.x * 8;
    bf16_t* XN = (bf16_t*)(a.ws() + WS_XN); const float* H = a.out();
    for (int m = gw; m < NTOK; m += NGW) rms_row_bf16(H + (size_t)m * 1024, XN + (size_t)m * 1024, lane);
}
__device__ __forceinline__ void ph_final_norm(KA a) {
    const int lane = threadIdx.x & 63, wave = __builtin_amdgcn_readfirstlane(threadIdx.x >> 6), gw = blockIdx.x * 8 + wave, NGW = gridDim.x * 8;
    const f32x4* gp = (const f32x4*)a.in(I_GFIN) + lane; f32x4 gg[4]; float* H = a.out();
#pragma unroll
    for (int j = 0; j < 4; ++j) gg[j] = gp[64 * j];
    for (int m = gw; m < NTOK; m += NGW) {
        f32x4* xr = (f32x4*)(H + (size_t)m * 1024) + lane; f32x4 v[4]; float s = 0.f;
#pragma unroll
        for (int j = 0; j < 4; ++j) { v[j] = xr[64 * j]; s += (v[j].x * v[j].x + v[j].y * v[j].y) + (v[j].z * v[j].z + v[j].w * v[j].w); }
        const float r = 1.0f / sqrtf(wave_sum(s) * (1.0f / 1024.0f) + EPS);
#pragma unroll
        for (int j = 0; j < 4; ++j) xr[64 * j] = v[j] * r * gg[j];
    }
}

__global__ void __launch_bounds__(512, 2) mk_fwd(Args args) {
    extern __shared__ __attribute__((aligned(16))) unsigned char lds_raw[];
    LAS unsigned char* lds = (LAS unsigned char*)lds_raw;
    const int tid = threadIdx.x;
    volatile LAS unsigned* MISC = (volatile LAS unsigned*)(lds + MISC_OFF);
    for (int u = tid; u < 64; u += 512) MISC[u] = 0u;
    __syncthreads();
    const KA ka{};
    XcdBarrier bar; bar.bar = nullptr; bar.x = 0; bar.st = nullptr;
    if (MK_N_LAUNCHES == 1) bar = xcd_barrier_post((unsigned*)(ka.ws() + WS_CTL) + CW_BAR, MISC + 8);
    const int lo = args.ph_lo, hi = args.ph_hi;
#define IN(k) (lo <= (k) && (k) < hi)
#define SEAM(k) do { if (IN(k) && IN((k) + 1)) xcd_barrier(bar); } while (0)
#define WSP(T, off) ((T*)(ws + (off)))

    if (IN(0)) { ph_prep(ka, lds); } SEAM(0);
    if (IN(1)) { unsigned char* ws = ka.ws(); ProbDense P{WSP(const bf16_t, WS_XN), WSP(const bf16_t, WS_BT_IN), 1024, 1024, 1024, 128, 8}; EpiIn E{WSP(bf16_t, WS_P)}; run_gemm(lds, P, E); } SEAM(1);
    if (IN(2)) { ph_pool(ka); ph_attn_naive(ka); } SEAM(2);
    if (IN(3)) { unsigned char* ws = ka.ws(); ProbDense P{WSP(const bf16_t, WS_MIX), WSP(const bf16_t, WS_BT_OUT), 1024, 1024, 1024, 128, 4}; EpiRes E{ka.in(I_X), ka.out()}; run_gemm(lds, P, E); } SEAM(3);
#define MOE_LAYER(layer, pb) do { \
        if (IN(pb)) { ph_route(ka, lds, layer); } SEAM(pb); \
        if (IN((pb) + 1)) { const MoeTab tab = moe_table(ka, lds, layer); unsigned char* ws = ka.ws(); \
            ProbGU P{WSP(const bf16_t, WS_XN), WSP(const bf16_t, WS_GU + (size_t)(layer) * 16 * MiB), WSP(const int, WS_TOK), tab, 1024, 1024, 1024}; EpiGU E{WSP(bf16_t, WS_ACT), WSP(const f32x2, WS_CW), tab}; run_gemm(lds, P, E); } SEAM((pb) + 1); \
        if (IN((pb) + 2)) { const MoeTab tab = moe_table(ka, lds, layer); unsigned char* ws = ka.ws(); \
            ProbDN P{WSP(const bf16_t, WS_ACT), WSP(const bf16_t, WS_DN + (size_t)(layer) * 24 * MiB), tab, 512, 512, 512}; EpiDN E{ka.out(), WSP(const int, WS_TOK), tab}; run_gemm(lds, P, E); } SEAM((pb) + 2); } while (0)
    MOE_LAYER(0, 4);
    if (IN(7)) { ph_norm_xn(ka); } SEAM(7);
    if (IN(8)) { unsigned char* ws = ka.ws(); ProbDense P{WSP(const bf16_t, WS_XN), WSP(const bf16_t, WS_BT_SIN), 1024, 1024, 1024, 128, 8}; EpiSin E{WSP(bf16_t, WS_U), WSP(bf16_t, WS_V1), ka.in(I_SBIN)}; run_gemm(lds, P, E); } SEAM(8);
    if (IN(9)) { ph_sgu_naive(ka, lds); } SEAM(9);
    if (IN(10)) { unsigned char* ws = ka.ws(); float* H = ka.out(); ProbDense P{WSP(const bf16_t, WS_MIX), WSP(const bf16_t, WS_BT_SOUT), 1024, 1024, 1024, 128, 4}; EpiRes E{H, H}; run_gemm(lds, P, E); } SEAM(10);
    MOE_LAYER(1, 11);
#undef MOE_LAYER
    if (IN(14)) { ph_final_norm(ka); }
#undef IN
#undef SEAM
#undef WSP
}

extern "C" void kernel_launch(void* const* d_in, const int* in_sizes, int n_in, void* d_out, int out_size, void* d_ws, size_t ws_size, hipStream_t stream) {
    static int grid = 0;
    if (grid == 0) {
        if (n_in != 23 || out_size != NTOK * DM || ws_size < WS_END) { fprintf(stderr, "kernel_launch: unexpected shapes (n_in %d out %d ws %zu)\n", n_in, out_size, ws_size); grid = -1; return; }
        int dev = 0, cus = 0, per_cu = 0;
        if (hipGetDevice(&dev) != hipSuccess || hipDeviceGetAttribute(&cus, hipDeviceAttributeMultiprocessorCount, dev) != hipSuccess) { grid = -1; return; }
        if (hipFuncSetAttribute((const void*)mk_fwd, hipFuncAttributeMaxDynamicSharedMemorySize, LDS_BYTES) != hipSuccess) { fprintf(stderr, "kernel_launch: hipFuncSetAttribute failed\n"); grid = -1; return; }
        if (hipOccupancyMaxActiveBlocksPerMultiprocessor(&per_cu, (const void*)mk_fwd, 512, LDS_BYTES) != hipSuccess || per_cu < 1) { fprintf(stderr, "kernel_launch: occupancy query says %d\n", per_cu); }
        (void)hipGetLastError();
        grid = cus;
    }
    if (grid < 0) return;
    (void)hipMemsetAsync((char*)d_ws + WS_CTL, 0, CTL_ZERO_BYTES, stream);
    Args a{};
    for (int i = 0; i < 23; ++i) a.in[i] = (const float*)d_in[i];
    a.out = (float*)d_out; a.ws = (unsigned char*)d_ws;
    if (MK_N_LAUNCHES == 1) { a.ph_lo = 0; a.ph_hi = NPHASE; hipLaunchKernelGGL(mk_fwd, dim3(grid), dim3(512), LDS_BYTES, stream, a); }
    else { for (int p = 0; p < NPHASE; ++p) { a.ph_lo = p; a.ph_hi = p + 1; hipLaunchKernelGGL(mk_fwd, dim3(grid), dim3(512), LDS_BYTES, stream, a); } }
}
```

```cpp
#include <hip/hip_runtime.h>
#include <cstdio>
#include <cstdint>

#ifndef MK_N_LAUNCHES
#define MK_N_LAUNCHES 1
#endif
#ifndef NAIVE_GEMM
#define NAIVE_GEMM 0
#endif
#ifndef NAIVE_ATTN
#define NAIVE_ATTN 0
#endif
#ifndef NAIVE_SGU
#define NAIVE_SGU 0
#endif

#define LAS __attribute__((address_space(3)))
#define GAS __attribute__((address_space(1)))
typedef unsigned short bf16_t;
typedef short bf16x8 __attribute__((ext_vector_type(8)));
typedef float f32x4 __attribute__((ext_vector_type(4)));
typedef float f32x2 __attribute__((ext_vector_type(2)));
typedef unsigned u32x4 __attribute__((ext_vector_type(4)));
typedef unsigned u32x2 __attribute__((ext_vector_type(2)));
typedef GAS unsigned gu32;
#define RLX_AGENT __ATOMIC_RELAXED, __HIP_MEMORY_SCOPE_AGENT

constexpr int NTOK = 32768, DM = 1024, SEQ = 4096, NBATCH = 8;
constexpr float EPS = 1e-6f, LOG2E = 1.4426950408889634f, C2 = 0.125f * 1.4426950408889634f;
constexpr int NBUCKET = 24, ACT_ROWS = NTOK + NBUCKET * 256, NPHASE = 15;

constexpr size_t MiB = 1u << 20;
constexpr size_t WS_CTL = 0, CTL_ZERO_BYTES = 1 * MiB;
constexpr size_t WS_BT_IN = 2 * MiB, WS_BT_OUT = 6 * MiB, WS_BT_SIN = 8 * MiB, WS_BT_SOUT = 12 * MiB, WS_WS = 14 * MiB;
constexpr size_t WS_GU = 16 * MiB  , WS_DN = 48 * MiB  ;
constexpr size_t WS_XN = 96 * MiB;
constexpr size_t WS_P = 160 * MiB, WS_Q = 192 * MiB, WS_K = 224 * MiB, WS_V = 256 * MiB;
constexpr size_t WS_U = 160 * MiB, WS_V1 = 224 * MiB;
constexpr size_t WS_MIX = 288 * MiB;
constexpr size_t WS_ACT = 352 * MiB;
constexpr size_t WS_TOK = 392 * MiB;
constexpr size_t WS_CW = 396 * MiB;
constexpr size_t WS_END = 404 * MiB;
constexpr int CW_CNT = 64;
constexpr int CW_BAR = 4096;

constexpr int RING_BYTES = 131072;
constexpr int MISC_OFF = RING_BYTES;
constexpr int TAB_OFF = RING_BYTES + 256;
constexpr int STASH_OFF = RING_BYTES + 2048;
constexpr int LDS_BYTES = 147456;

__device__ __forceinline__ unsigned f2bf(float f) { unsigned u = __builtin_bit_cast(unsigned, f); return (u + 0x7fffu + ((u >> 16) & 1u)) >> 16; }
__device__ __forceinline__ unsigned pk2(float lo, float hi) { return f2bf(lo) | (f2bf(hi) << 16); }
__device__ __forceinline__ float bf2f(unsigned short b) { return __builtin_bit_cast(float, (unsigned)b << 16); }
__device__ __forceinline__ float bflo(unsigned w) { return __builtin_bit_cast(float, w << 16); }
__device__ __forceinline__ float bfhi(unsigned w) { return __builtin_bit_cast(float, w & 0xffff0000u); }
__device__ __forceinline__ float wave_sum(float v) {
#pragma unroll
    for (int o = 1; o < 64; o <<= 1) v += __shfl_xor(v, o);
    return v;
}
__device__ __forceinline__ float wave_max(float v) {
#pragma unroll
    for (int o = 1; o < 64; o <<= 1) v = fmaxf(v, __shfl_xor(v, o));
    return v;
}
#define LDS_WAIT() asm volatile("s_waitcnt lgkmcnt(0)" ::: "memory")
__device__ __forceinline__ int pair_lo(int p) { return (0x211000 >> (4 * p)) & 0xF; }
__device__ __forceinline__ int pair_hi(int p) { return (0x332321 >> (4 * p)) & 0xF; }

__device__ __forceinline__ f32x2 gelu_pk(f32x2 v) {
    const f32x2 av = __builtin_elementwise_abs(v), d = av * 0.2316418882f + 1.0f;
    f32x2 t; t.x = __builtin_amdgcn_rcpf(d.x); t.y = __builtin_amdgcn_rcpf(d.y);
    f32x2 q = t * 0.5307027145f + (-0.7265760135f); q = q * t + 0.7107068705f; q = q * t + (-0.142248368f); q = q * t + 0.127414796f; q = q * t;
    const f32x2 s = (v * v) * (-0.72134752044f);
    f32x2 e; e.x = __builtin_amdgcn_exp2f(s.x); e.y = __builtin_amdgcn_exp2f(s.y);
    const f32x2 m = v * (q * e), r = v - m;
    f32x2 o; o.x = v.x < 0.f ? m.x : r.x; o.y = v.y < 0.f ? m.y : r.y; return o;
}
__device__ __forceinline__ f32x4 gelu4(f32x4 v) { f32x2 a = gelu_pk((f32x2){v[0], v[1]}), b = gelu_pk((f32x2){v[2], v[3]}); return (f32x4){a.x, a.y, b.x, b.y}; }
__device__ __forceinline__ float silu1(float x) { return x * __builtin_amdgcn_rcpf(1.0f + __builtin_amdgcn_exp2f(-x * LOG2E)); }

struct Args { const float* in[23]; float* out; unsigned char* ws; int ph_lo, ph_hi; };
__device__ __forceinline__ unsigned long long karg_u64(int byte_off) {
    asm volatile("" : "+s"(byte_off));
    const __attribute__((address_space(4))) unsigned char* kp = (const __attribute__((address_space(4))) unsigned char*)__builtin_amdgcn_kernarg_segment_ptr();
    const unsigned long long v = *(const __attribute__((address_space(4))) unsigned long long*)(kp + byte_off);
    const unsigned lo = __builtin_amdgcn_readfirstlane((unsigned)v), hi = __builtin_amdgcn_readfirstlane((unsigned)(v >> 32));
    return ((unsigned long long)hi << 32) | lo;
}
struct KA {
    __device__ __forceinline__ const float* in(int i) const { return (const float*)(const GAS float*)karg_u64(i * 8); }
    __device__ __forceinline__ float* out() const { return (float*)(GAS float*)karg_u64(23 * 8); }
    __device__ __forceinline__ unsigned char* ws() const { return (unsigned char*)(GAS unsigned char*)karg_u64(24 * 8); }
};
enum { I_X = 0, I_GMIX, I_GFFN, I_GFIN, I_WIN, I_POOLW, I_POOLS, I_RELB, I_WOUT, I_SWIN, I_SBIN, I_SLNG, I_SLNB, I_SWS, I_SBS, I_SWOUT,
       I_WGR, I_BGR, I_WER, I_BER, I_WG, I_WU, I_WD };

#define XB_TMO      128
#define XB_XCNT(j)  (256  + 64 * (j))
#define XB_XSUB(j)  (1280 + 64 * (j))
#define XB_XGEN(j)  (2304 + 64 * (j))
#define XB_TOP      3328
#define XB_TOPGEN   3392
#define XCD_BAR_WORDS 3456
#define XB_SPIN_CAP (1u << 18)
__device__ __forceinline__ unsigned xb_ld(unsigned* p)              { return __hip_atomic_load(p, __ATOMIC_RELAXED, __HIP_MEMORY_SCOPE_AGENT); }
__device__ __forceinline__ unsigned xb_add(unsigned* p, unsigned v) { return __hip_atomic_fetch_add(p, v, __ATOMIC_RELAXED, __HIP_MEMORY_SCOPE_AGENT); }
__device__ __forceinline__ unsigned xb_xcc_id() { return (unsigned)__builtin_amdgcn_s_getreg((3 << 11) | 20) & 0xFu; }
#define XB_SPIN(cond, bar) do { unsigned _sp = 0; while (cond) { __builtin_amdgcn_s_sleep(1); \
    if ((++_sp & 255u) == 0u) { if (xb_ld(&(bar)[XB_TMO])) break; if (_sp > XB_SPIN_CAP) { atomicAdd(&(bar)[XB_TMO], 1u); break; } } } } while (0)
struct XcdBarrier { unsigned* bar; unsigned x; volatile LAS unsigned* st; };
__device__ __forceinline__ XcdBarrier xcd_barrier_post(unsigned* bar, volatile LAS unsigned* st) {
    XcdBarrier b; b.bar = bar; b.x = xb_xcc_id(); b.st = st;
    if (threadIdx.x == 0) (void)xb_add(&bar[XB_XCNT(b.x)], 1u);
    return b;
}
__device__ __forceinline__ void xcd_barrier_complete(unsigned* bar, unsigned x, unsigned& nloc, unsigned& nx) {
    const unsigned G = gridDim.x * gridDim.y * gridDim.z;
    unsigned sum, cnt, mine, sp = 0u;
    for (;;) {
        sum = 0u; cnt = 0u; mine = 0u;
#pragma unroll
        for (unsigned j = 0; j < 16; ++j) { const unsigned c = xb_ld(&bar[XB_XCNT(j)]); sum += c; cnt += (c > 0u) ? 1u : 0u; mine = (j == x) ? c : mine; }
        if (sum == G) break;
        __builtin_amdgcn_s_sleep(1);
        if ((++sp & 255u) == 0u) { if (xb_ld(&bar[XB_TMO])) break; if (sp > XB_SPIN_CAP) { atomicAdd(&bar[XB_TMO], 1u); break; } }
    }
    nloc = mine > 0u ? mine : 1u; nx = cnt > 0u ? cnt : 1u;
}
__device__ __forceinline__ void xcd_barrier(const XcdBarrier& b) {
    asm volatile("s_waitcnt vmcnt(0)" ::: "memory");
    __syncthreads();
    if (threadIdx.x == 0) {
        unsigned* bar = b.bar;
        __builtin_amdgcn_s_waitcnt(0);
        unsigned nloc = b.st[0], nx = b.st[1];
        if (nloc == 0u) { xcd_barrier_complete(bar, b.x, nloc, nx); b.st[0] = nloc; b.st[1] = nx; }
        const unsigned old = xb_add(&bar[XB_XSUB(b.x)], 1u);
        const unsigned gen = old / nloc;
        if (old + 1u == (gen + 1u) * nloc) {
            __builtin_amdgcn_fence(__ATOMIC_RELEASE, "agent");
            asm volatile("s_waitcnt vmcnt(0)" ::: "memory");
            const unsigned og = xb_add(&bar[XB_TOP], 1u);
            const unsigned tg = og / nx;
            if (og + 1u == (tg + 1u) * nx) xb_add(&bar[XB_TOPGEN], 1u);
            else XB_SPIN(xb_ld(&bar[XB_TOPGEN]) == tg, bar);
            __builtin_amdgcn_fence(__ATOMIC_ACQUIRE, "agent");
            xb_add(&bar[XB_XGEN(b.x)], 1u);
            asm volatile("s_waitcnt vmcnt(0)" ::: "memory");
        } else {
            XB_SPIN(xb_ld(&bar[XB_XGEN(b.x)]) == gen, bar);
            __builtin_amdgcn_fence(__ATOMIC_ACQUIRE, "agent");
            asm volatile("s_waitcnt vmcnt(0)" ::: "memory");
        }
    }
    __syncthreads();
}

struct Unit { int pm, pn; };
struct MoeTab { const LAS int* tb; const LAS int* tf; const LAS int* cnt; int T;
    __device__ __forceinline__ int bucket(int pm) const { return __builtin_amdgcn_readfirstlane(tb[pm]); }
    __device__ __forceinline__ int first(int pm) const { return __builtin_amdgcn_readfirstlane(tf[pm]); }
    __device__ __forceinline__ int count(int b) const { return __builtin_amdgcn_readfirstlane(cnt[b]); }
};

struct ProbDense {
    static constexpr bool GATHER = false;
    const bf16_t* A; const bf16_t* Bt; int lda, ldb, K, nM, nN;
    __device__ __forceinline__ int n_m() const { return nM; }
    __device__ __forceinline__ int n_n() const { return nN; }
    __device__ __forceinline__ unsigned a_off(int pm, int R) const { return (unsigned)(pm * 256 + R) * (unsigned)(lda * 2); }
    __device__ __forceinline__ const char* b_base(int pm, int pn) const { return (const char*)Bt + (size_t)pn * 256 * ldb * 2; }
};
struct ProbGU {
    static constexpr bool GATHER = true;
    const bf16_t* A; const bf16_t* GU; const int* toklist; MoeTab tab; int lda, ldb, K;
    __device__ __forceinline__ int n_m() const { return tab.T; }
    __device__ __forceinline__ int n_n() const { return 4; }
    __device__ __forceinline__ unsigned a_off(int pm, int R) const {
        const int b = tab.bucket(pm), idx = tab.first(pm) * 256 + R; const int tok = idx < tab.count(b) ? toklist[b * NTOK + idx] : 0;
        return (unsigned)tok * 2048u; }
    __device__ __forceinline__ const char* b_base(int pm, int pn) const {
        const int b = tab.bucket(pm), g = b / 6, p = b % 6, e = g * 4 + ((pn >> 1) ? pair_hi(p) : pair_lo(p));
        return (const char*)GU + ((size_t)e * 512 + (size_t)(pn & 1) * 256) * 2048; }
};
struct ProbDN {
    static constexpr bool GATHER = false;
    const bf16_t* A; const bf16_t* DN; MoeTab tab; int lda, ldb, K;
    __device__ __forceinline__ int n_m() const { return tab.T; }
    __device__ __forceinline__ int n_n() const { return 4; }
    __device__ __forceinline__ unsigned a_off(int pm, int R) const { return (unsigned)(pm * 256 + R) * 1024u; }
    __device__ __forceinline__ const char* b_base(int pm, int pn) const { const int b = tab.bucket(pm); return (const char*)DN + ((size_t)b * 1024 + (size_t)pn * 256) * 1024; }
};

__device__ __forceinline__ void st_bf4(bf16_t* p, f32x4 v) { u32x2 w; w.x = pk2(v[0], v[1]); w.y = pk2(v[2], v[3]); *(u32x2*)p = w; }
struct EpiIn {
    bf16_t* base;
    struct Row { bf16_t* d; };
    __device__ __forceinline__ Row row(int pm, int pn, int r) const { Row c; c.d = base + (size_t)(pn >> 1) * NTOK * 512 + (size_t)(pm * 256 + r) * 512 + (pn & 1) * 256; return c; }
    __device__ __forceinline__ void elem(const Row& c, int cq, f32x4 v0, f32x4 v1) const { st_bf4(c.d + cq, v0); st_bf4(c.d + 128 + cq, v1); }
};
struct EpiRes {
    const float* res; float* out;
    struct Row { const float* r; float* o; };
    __device__ __forceinline__ Row row(int pm, int pn, int r) const { const size_t o = (size_t)(pm * 256 + r) * 1024 + pn * 256; Row c; c.r = res + o; c.o = out + o; return c; }
    __device__ __forceinline__ void elem(const Row& c, int cq, f32x4 v0, f32x4 v1) const {
        *(f32x4*)(c.o + cq) = *(const f32x4*)(c.r + cq) + v0; *(f32x4*)(c.o + cq + 128) = *(const f32x4*)(c.r + cq + 128) + v1; }
};
struct EpiGU {
    bf16_t* act; const f32x2* cwl; MoeTab tab;
    struct Row { bf16_t* d; float cw; };
    __device__ __forceinline__ Row row(int pm, int pn, int r) const {
        const int b = tab.bucket(pm), idx = tab.first(pm) * 256 + r; Row c; c.cw = 0.f;
        if (idx < tab.count(b)) { const f32x2 w = cwl[b * NTOK + idx]; c.cw = (pn >> 1) ? w.y : w.x; }
        c.d = act + (size_t)(pm * 256 + r) * 512 + (pn >> 1) * 256 + (pn & 1) * 128; return c; }
    __device__ __forceinline__ void elem(const Row& c, int cq, f32x4 v0, f32x4 v1) const {
        f32x4 o;
#pragma unroll
        for (int j = 0; j < 4; ++j) o[j] = silu1(v0[j]) * v1[j] * c.cw;
        st_bf4(c.d + cq, o); }
};
struct EpiDN {
    float* h; const int* toklist; MoeTab tab;
    struct Row { float* p; };
    __device__ __forceinline__ Row row(int pm, int pn, int r) const {
        const int b = tab.bucket(pm), idx = tab.first(pm) * 256 + r; Row c; c.p = nullptr;
        if (idx < tab.count(b)) { const int tok = toklist[b * NTOK + idx]; c.p = h + (size_t)tok * 1024 + pn * 256; } return c; }
    __device__ __forceinline__ void elem(const Row& c, int cq, f32x4 v0, f32x4 v1) const {
        if (c.p) { float* p = c.p + cq; *(f32x4*)p = *(const f32x4*)p + v0; *(f32x4*)(p + 128) = *(const f32x4*)(p + 128) + v1; } }
};
struct EpiSin {
    bf16_t* U; bf16_t* V1; const float* bias;
    struct Row { bf16_t* d; const float* b; };
    __device__ __forceinline__ Row row(int pm, int pn, int r) const { Row c; c.d = (pn < 4 ? U + pn * 256 : V1 + (pn - 4) * 256) + (size_t)(pm * 256 + r) * 1024; c.b = bias + pn * 256; return c; }
    __device__ __forceinline__ void elem(const Row& c, int cq, f32x4 v0, f32x4 v1) const {
        const f32x4 b0 = *(const f32x4*)(c.b + cq), b1 = *(const f32x4*)(c.b + cq + 128);
        st_bf4(c.d + cq, gelu4(v0 + b0)); st_bf4(c.d + cq + 128, gelu4(v1 + b1)); }
};

template <class Prob, class Epi>
__device__ __forceinline__ void gemm_naive(LAS unsigned char* lds, const Prob& P, const Epi& E) {
    const int tid = threadIdx.x;
    LAS float* As = (LAS float*)lds;
    LAS float* Bs = (LAS float*)(lds + 8192);
    const int nsub = P.n_m() * P.n_n() * 4;
    const int cq = (tid & 31) * 4, rg = tid >> 5;
    for (int su = blockIdx.x; su < nsub; su += gridDim.x) {
        const int un = su >> 2, sb = su & 3, pm = un / P.n_n(), pn = un % P.n_n();
        f32x4 acc0[4], acc1[4];
#pragma unroll
        for (int i = 0; i < 4; ++i) { acc0[i] = (f32x4){0.f, 0.f, 0.f, 0.f}; acc1[i] = acc0[i]; }
        const char* Bb = P.b_base(pm, pn);
        const char* Ab = (const char*)P.A;
        unsigned aoff = 0; if (tid < 256) aoff = P.a_off(pm, sb * 64 + (tid >> 2)) + (tid & 3) * 16;
        for (int k0 = 0; k0 < P.K; k0 += 32) {
            __syncthreads();
            if (tid < 256) { const u32x4 w = *(const u32x4*)(Ab + aoff + k0 * 2); const int row = tid >> 2, ch = tid & 3;
#pragma unroll
                for (int j = 0; j < 4; ++j) { As[(ch * 8 + 2 * j) * 64 + row] = bflo(w[j]); As[(ch * 8 + 2 * j + 1) * 64 + row] = bfhi(w[j]); } }
#pragma unroll
            for (int i = 0; i < 2; ++i) { const int idx = tid + 512 * i, c = idx >> 2, ch = idx & 3;
                const u32x4 w = *(const u32x4*)(Bb + ((size_t)c * P.ldb + k0 + ch * 8) * 2);
#pragma unroll
                for (int j = 0; j < 4; ++j) { Bs[(ch * 8 + 2 * j) * 256 + c] = bflo(w[j]); Bs[(ch * 8 + 2 * j + 1) * 256 + c] = bfhi(w[j]); } }
            __syncthreads();
#pragma unroll 4
            for (int kk = 0; kk < 32; ++kk) {
                const f32x4 b0 = *(const LAS f32x4*)(Bs + kk * 256 + cq), b1 = *(const LAS f32x4*)(Bs + kk * 256 + 128 + cq);
#pragma unroll
                for (int i = 0; i < 4; ++i) { const float a = As[kk * 64 + rg + 16 * i]; acc0[i] += b0 * a; acc1[i] += b1 * a; }
            }
        }
#pragma unroll
        for (int i = 0; i < 4; ++i) { const typename Epi::Row rc = E.row(pm, pn, sb * 64 + rg + 16 * i); E.elem(rc, cq, acc0[i], acc1[i]); }
    }
    __syncthreads();
}

namespace pg8 {
constexpr int BM = 256, BK = 64, HALF = 128, HTB = HALF * BK * 2, STAGE_BYTES = 8 * HTB, NXCD = 8, WGM = 8;
__host__ __device__ __forceinline__ int lds_byte(int r, int c) { const int st = (r >> 4) * 2 + (c >> 5), rr = r & 15, cc = c & 31, ob = rr * 64 + cc * 2; return st * 1024 + (ob ^ (((ob >> 9) & 1) << 5)); }
__host__ __device__ __forceinline__ void stage_rc(int b, int& R, int& C) { const int st = b / 1024, sb = b % 1024, swz = sb ^ (((sb >> 9) & 1) << 5); R = (st >> 1) * 16 + swz / 64; C = (st & 1) * 32 + (swz % 64) / 2; }
struct StaticOrder {
    int nM, nN, nwg, G, c;
    __device__ __forceinline__ void init(int nM_, int nN_, int G_, int c_) { nM = nM_; nN = nN_; nwg = nM * nN; G = G_; c = c_; }
    __device__ __forceinline__ bool next(int i, Unit& u) const {
        const long L = (long)i * G + c; if (L >= nwg) return false;
        int wgid = (int)L; { const int q = nwg / NXCD, r = nwg % NXCD, xcd = wgid % NXCD, off = wgid / NXCD; wgid = (xcd < r ? xcd * (q + 1) : r * (q + 1) + (xcd - r) * q) + off; }
        const int nig = WGM * nN, gid = wgid / nig, fm = gid * WGM, gsz = (nM - fm) < WGM ? (nM - fm) : WGM;
        u.pm = fm + ((wgid % nig) % gsz); u.pn = (wgid % nig) / gsz; return true;
    }
};

template <class Prob, class Epi>
__device__ __forceinline__ void gemm_phase(LAS unsigned char* lds, const Prob& P, const Epi& E) {
    const int tid = threadIdx.x, wid = __builtin_amdgcn_readfirstlane(tid >> 6), lane = tid & 63, wr = wid >> 2, wc = wid & 3, fr = lane & 15, fq = lane >> 4;
    const int K = P.K, nt = K / BK;
    StaticOrder S; S.init(P.n_m(), P.n_n(), (int)gridDim.x, (int)blockIdx.x);
    unsigned voffB[2];
#pragma unroll
    for (int i = 0; i < 2; ++i) { int R, C; stage_rc(tid * 16 + i * 8192, R, C); voffB[i] = (unsigned)(R * P.ldb + C) * 2u; }
    const size_t kstep = (size_t)(BK * 2);
    const size_t hstepB = (size_t)HALF * P.ldb * 2;
    const unsigned ldsw = (unsigned)wid * 1024u;
    const int aoff = lds_byte(wr * 64 + fr, fq * 8), boff = lds_byte(wc * 32 + fr, fq * 8);
    const char* Abase = (const char*)P.A;
#define PG8_SA(b, h) (((b) * 2 + (h)) * HTB)
#define PG8_SB(b, h) ((4 + (b) * 2 + (h)) * HTB)
#define PG8_STAGEB(bufoff, gbase) do { _Pragma("unroll") for (int _i = 0; _i < 2; ++_i) \
        __builtin_amdgcn_global_load_lds((const unsigned*)((const char*)(gbase) + voffB[_i]), (LAS unsigned*)(lds + (bufoff) + ldsw + _i * 8192), 16, 0, 0); } while (0)
#define PG8_STAGEA(bufoff, va, h, kb) do { _Pragma("unroll") for (int _i = 0; _i < 2; ++_i) \
        __builtin_amdgcn_global_load_lds((const unsigned*)(Abase + (size_t)(va)[h][_i] + (kb)), (LAS unsigned*)(lds + (bufoff) + ldsw + _i * 8192), 16, 0, 0); } while (0)
#define PG8_LDA(dst, b, h) do { _Pragma("unroll") for (int m = 0; m < 4; ++m) _Pragma("unroll") for (int k = 0; k < 2; ++k) dst[m][k] = *(const LAS bf16x8*)(lds + PG8_SA(b, h) + aoff + m * 2048 + k * 1024); } while (0)
#define PG8_LDB(dst, b, h) do { _Pragma("unroll") for (int n = 0; n < 2; ++n) _Pragma("unroll") for (int k = 0; k < 2; ++k) dst[n][k] = *(const LAS bf16x8*)(lds + PG8_SB(b, h) + boff + n * 2048 + k * 1024); } while (0)
#define PG8_MMA(ai, bj, At, Bt) do { __builtin_amdgcn_s_setprio(1); _Pragma("unroll") for (int m = 0; m < 4; ++m) _Pragma("unroll") for (int n = 0; n < 2; ++n) _Pragma("unroll") for (int k = 0; k < 2; ++k) \
        acc[ai][bj][m][n] = __builtin_amdgcn_mfma_f32_16x16x32_bf16(Bt[n][k], At[m][k], acc[ai][bj][m][n], 0, 0, 0); __builtin_amdgcn_s_setprio(0); } while (0)
#define PG8_WAIT_V(n) asm volatile("s_waitcnt vmcnt(" #n ")" ::: "memory")
#define PG8_WAIT_L(n) asm volatile("s_waitcnt lgkmcnt(" #n ")" ::: "memory")
#define PG8_BAR __builtin_amdgcn_s_barrier()
#define PG8_SCHED __builtin_amdgcn_sched_barrier(0)
#define PG8_AOFFS(va, pm_) do { _Pragma("unroll") for (int _i = 0; _i < 2; ++_i) { int R_, C_; stage_rc(tid * 16 + _i * 8192, R_, C_); \
        (va)[0][_i] = P.a_off((pm_), R_) + (unsigned)C_ * 2u; (va)[1][_i] = P.a_off((pm_), HALF + R_) + (unsigned)C_ * 2u; } } while (0)
#define PG8_KBODY(VA2, B2, K1, K2, HOOK) do { \
            const char* b2_ = (B2); const char* b3_ = b2_ + kstep; const size_t k1_ = (K1), k2_ = (K2), k3_ = k2_ + kstep; \
            PG8_LDB(B0, 0, 0); PG8_LDB(B1, 0, 1); PG8_SCHED; PG8_LDA(At, 0, 0); PG8_STAGEA(PG8_SA(1, 1), vaC, 1, k1_); HOOK; \
            PG8_WAIT_V(8); PG8_WAIT_L(0); PG8_BAR; PG8_MMA(0, 0, At, B0); PG8_MMA(0, 1, At, B1); PG8_BAR; PG8_SCHED; \
            PG8_LDA(At, 0, 1); PG8_STAGEB(PG8_SB(0, 0), b2_); PG8_STAGEB(PG8_SB(0, 1), b2_ + hstepB); PG8_STAGEA(PG8_SA(0, 0), VA2, 0, k2_); \
            PG8_WAIT_V(8); PG8_WAIT_L(0); PG8_BAR; PG8_MMA(1, 0, At, B0); PG8_MMA(1, 1, At, B1); PG8_BAR; PG8_SCHED; \
            PG8_LDB(B0, 1, 0); PG8_LDB(B1, 1, 1); PG8_SCHED; PG8_LDA(At, 1, 0); PG8_STAGEA(PG8_SA(0, 1), VA2, 1, k2_); \
            PG8_WAIT_V(8); PG8_WAIT_L(0); PG8_BAR; PG8_MMA(0, 0, At, B0); PG8_MMA(0, 1, At, B1); PG8_BAR; PG8_SCHED; \
            PG8_LDA(At, 1, 1); PG8_STAGEB(PG8_SB(1, 0), b3_); PG8_STAGEB(PG8_SB(1, 1), b3_ + hstepB); PG8_STAGEA(PG8_SA(1, 0), VA2, 0, k3_); \
            PG8_WAIT_V(8); PG8_WAIT_L(0); PG8_BAR; PG8_MMA(1, 0, At, B0); PG8_MMA(1, 1, At, B1); PG8_BAR; PG8_SCHED; } while (0)
    Unit cur, nxt; int ui = 0;
    if (!S.next(0, cur)) return;
    f32x4 acc[2][2][4][2];
#pragma unroll
    for (int a = 0; a < 2; ++a)
#pragma unroll
        for (int b = 0; b < 2; ++b)
#pragma unroll
            for (int m = 0; m < 4; ++m)
#pragma unroll
                for (int n = 0; n < 2; ++n) acc[a][b][m][n] = (f32x4){0.f, 0.f, 0.f, 0.f};
    bf16x8 At[4][2], B0[2][2], B1[2][2];
    constexpr bool GATHER = Prob::GATHER;
    unsigned vaC[2][2], vaN[2][2];
    LAS u32x4* stash = (LAS u32x4*)(lds + STASH_OFF) + tid;
    PG8_AOFFS(vaC, cur.pm);
    const char* cB = P.b_base(cur.pm, cur.pn);
    PG8_STAGEB(PG8_SB(0, 0), cB); PG8_STAGEB(PG8_SB(0, 1), cB + hstepB); PG8_STAGEA(PG8_SA(0, 0), vaC, 0, 0); PG8_STAGEA(PG8_SA(0, 1), vaC, 1, 0);
    if (wr == 1) PG8_BAR;
    PG8_WAIT_V(2); PG8_BAR;
    PG8_STAGEB(PG8_SB(1, 0), cB + kstep); PG8_STAGEA(PG8_SA(1, 0), vaC, 0, kstep); PG8_STAGEB(PG8_SB(1, 1), cB + hstepB + kstep);
    PG8_WAIT_V(6); PG8_BAR;
    for (;;) {
        const bool has_next = S.next(ui + 1, nxt);
        const char* nB = cB;
        if constexpr (GATHER) {
            if (has_next) { nB = P.b_base(nxt.pm, nxt.pn); unsigned tmp[2][2]; PG8_AOFFS(tmp, nxt.pm); *stash = (u32x4){tmp[0][0], tmp[0][1], tmp[1][0], tmp[1][1]}; }
            for (int t = 0; t < nt; t += 2) {
                const bool last = (t == nt - 2);
                const size_t k2 = last ? 0 : (size_t)(t + 2) * kstep;
                PG8_KBODY(vaC, (last ? nB : cB) + k2, (size_t)(t + 1) * kstep, k2,
                          if (last && has_next) { const u32x4 w_ = *stash; vaC[0][0] = w_.x; vaC[0][1] = w_.y; vaC[1][0] = w_.z; vaC[1][1] = w_.w; });
            }
        } else {
            if (has_next) { nB = P.b_base(nxt.pm, nxt.pn); PG8_AOFFS(vaN, nxt.pm); }
            else {
#pragma unroll
                for (int h = 0; h < 2; ++h)
#pragma unroll
                    for (int i = 0; i < 2; ++i) vaN[h][i] = vaC[h][i];
            }
            for (int t = 0; t < nt; t += 2) {
                const bool last = (t == nt - 2);
                unsigned va2[2][2];
#pragma unroll
                for (int h = 0; h < 2; ++h)
#pragma unroll
                    for (int i = 0; i < 2; ++i) va2[h][i] = last ? vaN[h][i] : vaC[h][i];
                const size_t k2 = last ? 0 : (size_t)(t + 2) * kstep;
                PG8_KBODY(va2, (last ? nB : cB) + k2, (size_t)(t + 1) * kstep, k2, (void)0);
            }
        }
        if (wr == 0) PG8_BAR;
        {
#pragma unroll
            for (int ai = 0; ai < 2; ++ai)
#pragma unroll
                for (int m = 0; m < 4; ++m) {
                    const typename Epi::Row rc = E.row(cur.pm, cur.pn, ai * HALF + wr * 64 + m * 16 + fr);
#pragma unroll
                    for (int n = 0; n < 2; ++n) E.elem(rc, wc * 32 + n * 16 + 4 * fq, acc[ai][0][m][n], acc[ai][1][m][n]);
                    if (m & 1) asm volatile("" ::: "memory");
                }
        }
        if (!has_next) break;
#pragma unroll
        for (int a = 0; a < 2; ++a)
#pragma unroll
            for (int b = 0; b < 2; ++b)
#pragma unroll
                for (int m = 0; m < 4; ++m)
#pragma unroll
                    for (int n = 0; n < 2; ++n) acc[a][b][m][n] = (f32x4){0.f, 0.f, 0.f, 0.f};
        cur = nxt; cB = nB; ++ui;
        if constexpr (!GATHER) {
#pragma unroll
            for (int h = 0; h < 2; ++h)
#pragma unroll
                for (int i = 0; i < 2; ++i) vaC[h][i] = vaN[h][i];
        }
        if (wr == 1) PG8_BAR;
    }
    PG8_WAIT_V(0);
    PG8_BAR;
#undef PG8_SA
#undef PG8_SB
#undef PG8_STAGEA
#undef PG8_STAGEB
#undef PG8_LDA
#undef PG8_LDB
#undef PG8_MMA
#undef PG8_WAIT_V
#undef PG8_WAIT_L
#undef PG8_BAR
#undef PG8_SCHED
#undef PG8_AOFFS
#undef PG8_KBODY
}
}

template <class Prob, class Epi>
__device__ __forceinline__ void run_gemm(LAS unsigned char* lds, const Prob& P, const Epi& E) {
#if NAIVE_GEMM
    gemm_naive(lds, P, E);
#else
    pg8::gemm_phase(lds, P, E);
#endif
}

__device__ __forceinline__ void tr_item(const float* W, int ldw, int k0, int n0, bf16_t* dst, int ldd, int drow0, int dk0, const float* gain, float cs, LAS float* scr, int lane) {
#pragma unroll 8
    for (int i = 0; i < 32; ++i) { const int kk = 2 * i + (lane >> 5); float v = W[(size_t)(k0 + kk) * ldw + n0 + (lane & 31)]; if (gain) v *= gain[k0 + kk]; scr[kk * 33 + (lane & 31)] = v * cs; }
    LDS_WAIT(); asm volatile("" ::: "memory");
    const int c = lane & 7;
#pragma unroll
    for (int j = 0; j < 4; ++j) { const int n = (lane >> 3) + 8 * j; const LAS float* s = scr + (8 * c) * 33 + n;
        u32x4 o; o.x = pk2(s[0 * 33], s[1 * 33]); o.y = pk2(s[2 * 33], s[3 * 33]); o.z = pk2(s[4 * 33], s[5 * 33]); o.w = pk2(s[6 * 33], s[7 * 33]);
        *(u32x4*)(dst + (size_t)(drow0 + n) * ldd + dk0 + 8 * c) = o; }
    LDS_WAIT(); asm volatile("" ::: "memory");
}
__device__ __forceinline__ void fold_item(const float* Win, const float* pw, const float* pscale, const float* gain, bf16_t* BT, int ko, int nb, int lane) {
    const int n = nb * 64 + lane, g = nb >> 1, d = n & 127;
    const float* wrow = Win + (size_t)(ko * 8) * 2048 + g * 128;
    const float* pwc = pw + (size_t)g * 128 * 128 + d;
    float acc[8];
#pragma unroll
    for (int j = 0; j < 8; ++j) acc[j] = 0.f;
    for (int c = 0; c < 128; ++c) { const float w = pwc[c * 128];
#pragma unroll
        for (int j = 0; j < 8; ++j) acc[j] += wrow[j * 2048 + c] * w; }
    const float sc = pscale[n];
#pragma unroll
    for (int j = 0; j < 8; ++j) acc[j] *= sc * gain[ko * 8 + j];
    u32x4 o; o.x = pk2(acc[0], acc[1]); o.y = pk2(acc[2], acc[3]); o.z = pk2(acc[4], acc[5]); o.w = pk2(acc[6], acc[7]);
    *(u32x4*)(BT + (size_t)n * 1024 + ko * 8) = o;
}
__device__ __forceinline__ void rms_row_bf16(const float* xrow, bf16_t* orow, int lane) {
    const f32x4* xr = (const f32x4*)xrow + lane; f32x4 v[4]; float s = 0.f;
#pragma unroll
    for (int j = 0; j < 4; ++j) { v[j] = xr[64 * j]; s += (v[j].x * v[j].x + v[j].y * v[j].y) + (v[j].z * v[j].z + v[j].w * v[j].w); }
    const float r = 1.0f / sqrtf(wave_sum(s) * (1.0f / 1024.0f) + EPS);
    unsigned long long* o8 = (unsigned long long*)orow + lane;
#pragma unroll
    for (int j = 0; j < 4; ++j) o8[64 * j] = (unsigned long long)pk2(v[j].x * r, v[j].y * r) | ((unsigned long long)pk2(v[j].z * r, v[j].w * r) << 32);
}
__device__ __forceinline__ void ph_prep(KA a, LAS unsigned char* lds) {
    const int tid = threadIdx.x, lane = tid & 63, wave = __builtin_amdgcn_readfirstlane(tid >> 6);
    const int gw = blockIdx.x * 8 + wave, NGW = gridDim.x * 8;
    LAS float* scr = (LAS float*)(lds + wave * 16384);
    unsigned char* ws = a.ws();
    bf16_t* BT_IN = (bf16_t*)(ws + WS_BT_IN); bf16_t* BT_OUT = (bf16_t*)(ws + WS_BT_OUT); bf16_t* BT_SIN = (bf16_t*)(ws + WS_BT_SIN); bf16_t* BT_SOUT = (bf16_t*)(ws + WS_BT_SOUT);
    constexpr int N_FOLD = 1024, N_QKV = 768, N_OUT = 512, N_SIN = 1024, N_SOUT = 512, N_GU = 8192, N_DN = 12288;
    constexpr int NITEMS = N_FOLD + N_QKV + N_OUT + N_SIN + N_SOUT + N_GU + N_DN;
    for (int it = gw; it < NITEMS; it += NGW) {
        int r = it;
        if (r < N_FOLD) { fold_item(a.in(I_WIN), a.in(I_POOLW), a.in(I_POOLS), a.in(I_GMIX), BT_IN, r >> 3, r & 7, lane); continue; } r -= N_FOLD;
        if (r < N_QKV) { const int kb = r / 48, nb = r % 48, n0 = 512 + nb * 32; tr_item(a.in(I_WIN), 2048, kb * 64, n0, BT_IN, 1024, n0, kb * 64, a.in(I_GMIX), n0 < 1024 ? C2 : 1.0f, scr, lane); continue; } r -= N_QKV;
        if (r < N_OUT) { const int kb = r / 32, nb = r % 32; tr_item(a.in(I_WOUT), 1024, kb * 64, nb * 32, BT_OUT, 1024, nb * 32, kb * 64, nullptr, 1.0f, scr, lane); continue; } r -= N_OUT;
        if (r < N_SIN) { const int kb = r / 64, nb = r % 64; tr_item(a.in(I_SWIN), 2048, kb * 64, nb * 32, BT_SIN, 1024, nb * 32, kb * 64, a.in(I_GMIX) + 1024, 1.0f, scr, lane); continue; } r -= N_SIN;
        if (r < N_SOUT) { const int kb = r / 32, nb = r % 32; tr_item(a.in(I_SWOUT), 1024, kb * 64, nb * 32, BT_SOUT, 1024, nb * 32, kb * 64, nullptr, 1.0f, scr, lane); continue; } r -= N_SOUT;
        if (r < N_GU) { const int l = r / 4096, r1 = r % 4096, isup = r1 / 2048, r2 = r1 % 2048, e = r2 / 128, r3 = r2 % 128, kb = r3 / 8, nb = r3 % 8, n0 = nb * 32;
            const float* W = a.in(isup ? I_WU : I_WG) + (size_t)(l * 16 + e) * 1024 * 256;
            bf16_t* dst = (bf16_t*)(ws + WS_GU + (size_t)l * 16 * MiB) + (size_t)e * 512 * 1024;
            tr_item(W, 256, kb * 64, n0, dst, 1024, (n0 >> 7) * 256 + (n0 & 127) + isup * 128, kb * 64, a.in(I_GFFN) + l * 1024, 1.0f, scr, lane); continue; } r -= N_GU;
        { const int l = r / 6144, r1 = r % 6144, b = r1 / 256, r2 = r1 % 256, s = r2 / 128, r3 = r2 % 128, kb = r3 / 32, nb = r3 % 32;
            const int g = b / 6, p = b % 6, e = g * 4 + (s ? pair_hi(p) : pair_lo(p));
            const float* W = a.in(I_WD) + (size_t)(l * 16 + e) * 256 * 1024;
            bf16_t* dst = (bf16_t*)(ws + WS_DN + (size_t)l * 24 * MiB) + (size_t)b * 1024 * 512;
            tr_item(W, 1024, kb * 64, nb * 32, dst, 512, nb * 32, s * 256 + kb * 64, nullptr, 1.0f, scr, lane); }
    }
    { bf16_t* WSB = (bf16_t*)(ws + WS_WS); const float* w = a.in(I_SWS);
      for (int i = blockIdx.x * 512 + tid; i < 8 * 128 * 128; i += gridDim.x * 512) { const int t = (i >> 7) & 127, s = i & 127; WSB[i] = (bf16_t)f2bf(s <= t ? w[i] : 0.f); } }
    { bf16_t* XN = (bf16_t*)(ws + WS_XN); const float* x = a.in(I_X);
      for (int m = gw; m < NTOK; m += NGW) rms_row_bf16(x + (size_t)m * 1024, XN + (size_t)m * 1024, lane); }
}

__device__ __forceinline__ void ph_pool(KA a) {
    unsigned char* ws = a.ws();
    const bf16_t* P = (const bf16_t*)(ws + WS_P); bf16_t* MIX = (bf16_t*)(ws + WS_MIX);
    const int nthr = gridDim.x * 512;
    for (int i = blockIdx.x * 512 + threadIdx.x; i < NTOK * 64; i += nthr) {
        const int tok = i >> 6, n = (i & 63) * 8, w = 2 << (n >> 7), tp = tok & (SEQ - 1);
        const int start = (tp + 1 - w) > 0 ? (tp + 1 - w) : 0, cnt = tp + 1 - start;
        float s[8];
#pragma unroll
        for (int j = 0; j < 8; ++j) s[j] = 0.f;
        u32x4 self = (u32x4){0u, 0u, 0u, 0u};
        for (int q = 0; q < cnt; ++q) { const u32x4 v = *(const u32x4*)(P + (size_t)(tok - q) * 512 + n); if (q == 0) self = v;
#pragma unroll
            for (int j = 0; j < 4; ++j) { s[2 * j] += bflo(v[j]); s[2 * j + 1] += bfhi(v[j]); } }
        const float inv = 1.0f / (float)cnt; u32x4 o;
#pragma unroll
        for (int j = 0; j < 4; ++j) o[j] = pk2(s[2 * j] * inv - bflo(self[j]), s[2 * j + 1] * inv - bfhi(self[j]));
        *(u32x4*)(MIX + (size_t)tok * 1024 + n) = o;
    }
}
__device__ __forceinline__ void ph_attn_naive(KA a) {
    unsigned char* ws = a.ws();
    const bf16_t* Q = (const bf16_t*)(ws + WS_Q); const bf16_t* K = (const bf16_t*)(ws + WS_K); const bf16_t* V = (const bf16_t*)(ws + WS_V);
    bf16_t* MIX = (bf16_t*)(ws + WS_MIX); const float* relb = a.in(I_RELB);
    const int lane = threadIdx.x & 63, wave = __builtin_amdgcn_readfirstlane(threadIdx.x >> 6);
    const int gw = blockIdx.x * 8 + wave, NGW = gridDim.x * 8;
    for (int task = gw; task < NBATCH * 8 * SEQ; task += NGW) {
        const int s = task & (SEQ - 1), h = (task >> 12) & 7, b = task >> 15, c = s >> 6;
        const bf16_t* qrow = Q + (size_t)(b * SEQ + s) * 512 + h * 64;
        float q[64];
#pragma unroll
        for (int i = 0; i < 8; ++i) { const u32x4 w = *(const u32x4*)(qrow + i * 8);
#pragma unroll
            for (int j = 0; j < 4; ++j) { q[i * 8 + 2 * j] = bflo(w[j]); q[i * 8 + 2 * j + 1] = bfhi(w[j]); } }
        float mx = -1e30f, l = 0.f, o = 0.f;
#pragma unroll 1
        for (int i = 0; i < 9; ++i) {
            const int kb = c * 64 - 512 + 64 * i;
            if (kb < 0) continue;
            const int kp = kb + lane;
            const bf16_t* krow = K + (size_t)(b * SEQ + kp) * 512 + h * 64; float d = 0.f;
#pragma unroll
            for (int ii = 0; ii < 8; ++ii) { const u32x4 w = *(const u32x4*)(krow + ii * 8);
#pragma unroll
                for (int j = 0; j < 4; ++j) { d += q[ii * 8 + 2 * j] * bflo(w[j]); d += q[ii * 8 + 2 * j + 1] * bfhi(w[j]); } }
            int rel = kp - s; rel = rel < -128 ? -128 : (rel > 128 ? 128 : rel);
            const float sc = d + relb[h * 257 + rel + 128] * LOG2E;
            const float mn = fmaxf(mx, wave_max(sc)), alpha = exp2f(mx - mn), p = exp2f(sc - mn);
            mx = mn; l = l * alpha + wave_sum(p); o *= alpha;
            const bf16_t* vb = V + (size_t)(b * SEQ + kb) * 512 + h * 64 + lane;
            for (int l2 = 0; l2 < 64; ++l2) { const float pj = __builtin_bit_cast(float, __builtin_amdgcn_readlane(__builtin_bit_cast(int, p), l2)); o += pj * bf2f(vb[(size_t)l2 * 512]); }
        }
        MIX[(size_t)(b * SEQ + s) * 1024 + 512 + h * 64 + lane] = (bf16_t)f2bf(o / l);
    }
}


namespace att {
typedef float f32x16 __attribute__((ext_vector_type(16)));
typedef short s16x4 __attribute__((ext_vector_type(4)));
typedef __bf16 bf16x2_t __attribute__((ext_vector_type(2)));
constexpr int KOFF = 0, VOFF = 16384, EXT_OFF = 32768, WSF_OFF = 33792, OST_OFF = 36864;
__device__ __forceinline__ int crow(int r, int hi) { return (r & 3) + 8 * (r >> 2) + 4 * hi; }
__device__ __forceinline__ unsigned cvtpk(float lo, float hi) { f32x2 v = {lo, hi}; bf16x2_t b = __builtin_convertvector(v, bf16x2_t); return __builtin_bit_cast(unsigned, b); }
__device__ __forceinline__ void qkt(f32x16& p0, f32x16& p1, const LAS unsigned char* Kslot, const bf16x8* qr, int r32, int hi) {
    const LAS unsigned char* kb = Kslot + hi * 1024 + r32 * 16;
    f32x16 z;
#pragma unroll
    for (int r = 0; r < 16; ++r) z[r] = 0.f;
    p0 = z; p1 = z;
#pragma unroll
    for (int d0 = 0; d0 < 4; ++d0) {
        const bf16x8 b0 = *(const LAS bf16x8*)(kb + d0 * 2048), b1 = *(const LAS bf16x8*)(kb + d0 * 2048 + 512);
        p0 = __builtin_amdgcn_mfma_f32_32x32x16_bf16(b0, qr[d0], p0, 0, 0, 0);
        p1 = __builtin_amdgcn_mfma_f32_32x32x16_bf16(b1, qr[d0], p1, 0, 0, 0);
    }
}
__device__ __forceinline__ void pv(f32x16* o, int vb, bf16x8 pa0, bf16x8 pa1, bf16x8 pa2, bf16x8 pa3) {
#pragma unroll
    for (int d0 = 0; d0 < 2; ++d0) { s16x4 lo[4], hi[4];
#pragma unroll
        for (int ks = 0; ks < 4; ++ks) {
            asm volatile("ds_read_b64_tr_b16 %0,%1 offset:%c2" : "=&v"(lo[ks]) : "v"(vb), "i"(d0 * 4096 + ks * 1024) : "memory");
            asm volatile("ds_read_b64_tr_b16 %0,%1 offset:%c2" : "=&v"(hi[ks]) : "v"(vb), "i"(d0 * 4096 + ks * 1024 + 512) : "memory"); }
        asm volatile("s_waitcnt lgkmcnt(0)" ::: "memory"); __builtin_amdgcn_sched_barrier(0);
#define ATT_PK(k) (bf16x8){lo[k][0], lo[k][1], lo[k][2], lo[k][3], hi[k][0], hi[k][1], hi[k][2], hi[k][3]}
        o[d0] = __builtin_amdgcn_mfma_f32_32x32x16_bf16(pa0, ATT_PK(0), o[d0], 0, 0, 0);
        o[d0] = __builtin_amdgcn_mfma_f32_32x32x16_bf16(pa1, ATT_PK(1), o[d0], 0, 0, 0);
        o[d0] = __builtin_amdgcn_mfma_f32_32x32x16_bf16(pa2, ATT_PK(2), o[d0], 0, 0, 0);
        o[d0] = __builtin_amdgcn_mfma_f32_32x32x16_bf16(pa3, ATT_PK(3), o[d0], 0, 0, 0);
#undef ATT_PK
    }
}
__device__ __forceinline__ float half_swap_max(float m) { auto rr = __builtin_amdgcn_permlane32_swap(__builtin_bit_cast(unsigned, m), __builtin_bit_cast(unsigned, m), false, false); return fmaxf(__builtin_bit_cast(float, rr[0]), __builtin_bit_cast(float, rr[1])); }
__device__ __forceinline__ float half_swap_sum(float m) { auto rr = __builtin_amdgcn_permlane32_swap(__builtin_bit_cast(unsigned, m), __builtin_bit_cast(unsigned, m), false, false); return __builtin_bit_cast(float, rr[0]) + __builtin_bit_cast(float, rr[1]); }

__device__ __forceinline__ void attn_unit(int b, int h, int qb, const bf16_t* Q, const bf16_t* K, const bf16_t* V, bf16_t* MIX, const float* relb, LAS unsigned char* lds) {
    const int tid = threadIdx.x, lane = tid & 63, r32 = lane & 31, hi = lane >> 5, wid = __builtin_amdgcn_readfirstlane(tid >> 6);
    const int c = 4 * qb + (wid >> 1);
    const int kt0 = (4 * qb - 8) > 0 ? (4 * qb - 8) : 0, kt1 = 4 * qb + 3;
    LAS float* ext = (LAS float*)(lds + EXT_OFF); LAS float* wsf = (LAS float*)(lds + WSF_OFF) + wid * 64;
    __syncthreads();
    for (int i = tid; i < 255; i += 512) { int rel = i - 191; rel = rel < -128 ? -128 : (rel > 128 ? 128 : rel); ext[i] = relb[h * 257 + rel + 128] * LOG2E; }
    const size_t rowbase = (size_t)b * SEQ; const int q0 = qb * 256;
    const bf16_t* Qw = Q + (rowbase + q0 + wid * 32) * 512 + h * 64;
    bf16x8 qr[4];
#pragma unroll
    for (int d0 = 0; d0 < 4; ++d0) qr[d0] = *(const bf16x8*)(Qw + (size_t)r32 * 512 + d0 * 16 + hi * 8);
    const bf16_t* ksrc = K + (rowbase + lane) * 512 + h * 64 + wid * 8;
    const bf16_t* vsrc = V + (rowbase + 16 * (wid & 3) + (lane >> 2)) * 512 + h * 64 + (wid >> 2) * 32 + (lane & 3) * 8;
    LAS unsigned char* kdst = lds + KOFF + wid * 1024 + lane * 16; LAS unsigned char* vdst = lds + VOFF + wid * 1024 + lane * 16;
    const int vb0 = (int)(unsigned)(size_t)(lds + VOFF) + ((lane >> 4) & 1) * 32 + (lane & 3) * 8 + (4 * hi + ((lane & 15) >> 2)) * 64;
    u32x4 kreg = *(const u32x4*)(ksrc + (size_t)kt0 * 64 * 512), vreg = *(const u32x4*)(vsrc + (size_t)kt0 * 64 * 512);
    *(LAS u32x4*)kdst = kreg; *(LAS u32x4*)vdst = vreg;
    __syncthreads();
    float m = -1e30f, l = 0.f; f32x16 o[2];
#pragma unroll
    for (int r = 0; r < 16; ++r) { o[0][r] = 0.f; o[1][r] = 0.f; }
    int buf = 0;
    for (int kt = kt0; kt <= kt1; ++kt) {
        const bool has_next = kt < kt1;
        if (has_next) { kreg = *(const u32x4*)(ksrc + (size_t)(kt + 1) * 64 * 512); vreg = *(const u32x4*)(vsrc + (size_t)(kt + 1) * 64 * 512); }
        if (kt >= c - 8 && kt <= c) {
            f32x16 p0, p1;
            qkt(p0, p1, lds + KOFF + buf * 8192, qr, r32, hi);
            if (kt >= c - 2) {
                const int dt = 64 * (kt - c) - 32 * (wid & 1);
                const LAS float* e = ext + (dt + 191 - r32 + 4 * hi);
#pragma unroll
                for (int r = 0; r < 16; ++r) { p0[r] += e[(r & 3) + 8 * (r >> 2)]; p1[r] += e[32 + (r & 3) + 8 * (r >> 2)]; }
            } else { const float b0 = ext[0];
#pragma unroll
                for (int r = 0; r < 16; ++r) { p0[r] += b0; p1[r] += b0; } }
            float rm = fmaxf(p0[0], p1[0]);
#pragma unroll
            for (int r = 1; r < 16; ++r) rm = fmaxf(rm, fmaxf(p0[r], p1[r]));
            rm = half_swap_max(rm);
            const float mn = fmaxf(m, rm);
            if (__any(mn > m)) {
                const float alpha = __builtin_amdgcn_exp2f(m - mn); l *= alpha;
                if (hi == 0) wsf[r32] = alpha;
                LDS_WAIT();
#pragma unroll
                for (int r = 0; r < 16; ++r) { const float f = wsf[crow(r, hi)]; o[0][r] *= f; o[1][r] *= f; }
            }
            m = mn;
            float ps = 0.f;
#pragma unroll
            for (int r = 0; r < 16; ++r) { p0[r] = __builtin_amdgcn_exp2f(p0[r] - m); p1[r] = __builtin_amdgcn_exp2f(p1[r] - m); ps += p0[r] + p1[r]; }
            l += ps;
            u32x4 w0, w1, w2, w3;
#pragma unroll
            for (int j = 0; j < 4; ++j) { w0[j] = cvtpk(p0[2 * j], p0[2 * j + 1]); w1[j] = cvtpk(p0[8 + 2 * j], p0[8 + 2 * j + 1]); w2[j] = cvtpk(p1[2 * j], p1[2 * j + 1]); w3[j] = cvtpk(p1[8 + 2 * j], p1[8 + 2 * j + 1]); }
            pv(o, vb0 + buf * 8192, __builtin_bit_cast(bf16x8, w0), __builtin_bit_cast(bf16x8, w1), __builtin_bit_cast(bf16x8, w2), __builtin_bit_cast(bf16x8, w3));
        }
        if (has_next) { *(LAS u32x4*)(kdst + (buf ^ 1) * 8192) = kreg; *(LAS u32x4*)(vdst + (buf ^ 1) * 8192) = vreg; }
        __syncthreads();
        buf ^= 1;
    }
    l = half_swap_sum(l);
    if (hi == 0) wsf[32 + r32] = l;
    LDS_WAIT();
    LAS bf16_t* stg = (LAS bf16_t*)(lds + OST_OFF) + wid * 2048;
#pragma unroll
    for (int r = 0; r < 16; ++r) { const int orow = crow(r, hi); const float rl = __builtin_amdgcn_rcpf(wsf[32 + orow]);
        stg[orow * 64 + r32] = (bf16_t)f2bf(o[0][r] * rl); stg[orow * 64 + 32 + r32] = (bf16_t)f2bf(o[1][r] * rl); }
    LDS_WAIT();
    bf16_t* Ow = MIX + (rowbase + q0 + wid * 32) * 1024 + 512 + h * 64;
#pragma unroll
    for (int i = 0; i < 4; ++i) { const int row = i * 8 + (lane >> 3), ch = lane & 7; const u32x4 v = *(const LAS u32x4*)(stg + row * 64 + ch * 8); *(u32x4*)(Ow + (size_t)row * 1024 + ch * 8) = v; }
}
}
__device__ __forceinline__ void ph_attn(KA a, LAS unsigned char* lds) {
    unsigned char* ws = a.ws();
    const bf16_t* Q = (const bf16_t*)(ws + WS_Q); const bf16_t* K = (const bf16_t*)(ws + WS_K); const bf16_t* V = (const bf16_t*)(ws + WS_V);
    bf16_t* MIX = (bf16_t*)(ws + WS_MIX); const float* relb = a.in(I_RELB);
    const int bx = blockIdx.x, G = gridDim.x;
    if (G == 256) {
        for (int i = 0; i < 4; ++i) { const int qb = ((bx & 15) + 4 * i) & 15, pr = (bx >> 4) + 16 * i; att::attn_unit(pr >> 3, pr & 7, qb, Q, K, V, MIX, relb, lds); }
    } else {
        for (int u = bx; u < 1024; u += G) att::attn_unit(u >> 7, (u >> 4) & 7, u & 15, Q, K, V, MIX, relb, lds);
    }
    __syncthreads();
}

namespace sgu {
constexpr int IMG_OFF = 0, STAT_OFF = 32768, OST_OFF = 36864;
__device__ __forceinline__ int img_off(int s, int d) { return ((s >> 6) * 4 + (d >> 5)) * 4096 + ((s & 63) >> 4) * 1024 + (s & 15) * 64 + (d & 31) * 2; }
}
__device__ __forceinline__ void ph_sgu(KA a, LAS unsigned char* lds) {
    using att::f32x16; using att::s16x4;
    unsigned char* ws = a.ws();
    const bf16_t* U = (const bf16_t*)(ws + WS_U); const bf16_t* V1 = (const bf16_t*)(ws + WS_V1); const bf16_t* WSB = (const bf16_t*)(ws + WS_WS);
    bf16_t* MIX = (bf16_t*)(ws + WS_MIX); const float* slng = a.in(I_SLNG); const float* slnb = a.in(I_SLNB); const float* sbs = a.in(I_SBS);
    const int tid = threadIdx.x, lane = tid & 63, r32 = lane & 31, hi = lane >> 5, wid = __builtin_amdgcn_readfirstlane(tid >> 6);
    LAS float* stat = (LAS float*)(lds + sgu::STAT_OFF);
    LAS float* stg = (LAS float*)(lds + sgu::OST_OFF) + wid * 2048;
    const int tb = wid & 3, dh = wid >> 2;
    const int vb0 = (int)(unsigned)(size_t)(lds + sgu::IMG_OFF) + ((lane >> 4) & 1) * 32 + (lane & 3) * 8 + (4 * hi + ((lane & 15) >> 2)) * 64;
    for (int un = blockIdx.x; un < NTOK / 128; un += gridDim.x) {
        const int row0 = un * 128;
        __syncthreads();
        for (int i = 0; i < 16; ++i) { const int rr = wid * 16 + i; const u32x4* vr = (const u32x4*)(V1 + (size_t)(row0 + rr) * 1024) + lane * 2; float s = 0.f, q = 0.f;
#pragma unroll
            for (int c = 0; c < 2; ++c) { const u32x4 w = vr[c];
#pragma unroll
                for (int j = 0; j < 4; ++j) { const float x0 = bflo(w[j]), x1 = bfhi(w[j]); s += x0 + x1; q += x0 * x0 + x1 * x1; } }
            s = wave_sum(s); q = wave_sum(q); const float mean = s * (1.0f / 1024.0f), var = q * (1.0f / 1024.0f) - mean * mean;
            if (lane == 0) { stat[2 * rr] = mean; stat[2 * rr + 1] = 1.0f / sqrtf(var + EPS); } }
        __syncthreads();
#pragma unroll 1
        for (int h = 0; h < 8; ++h) {
            {
                const int d = (tid & 15) * 8, col = h * 128 + d;
                const f32x4 g0 = *(const f32x4*)(slng + col), g1 = *(const f32x4*)(slng + col + 4), b0 = *(const f32x4*)(slnb + col), b1 = *(const f32x4*)(slnb + col + 4);
#pragma unroll
                for (int i = 0; i < 4; ++i) { const int s = (tid >> 4) + 32 * i; const u32x4 w = *(const u32x4*)(V1 + (size_t)(row0 + s) * 1024 + col);
                    const float mu = stat[2 * s], rs = stat[2 * s + 1]; u32x4 o;
                    o.x = pk2((bflo(w.x) - mu) * rs * g0.x + b0.x, (bfhi(w.x) - mu) * rs * g0.y + b0.y); o.y = pk2((bflo(w.y) - mu) * rs * g0.z + b0.z, (bfhi(w.y) - mu) * rs * g0.w + b0.w);
                    o.z = pk2((bflo(w.z) - mu) * rs * g1.x + b1.x, (bfhi(w.z) - mu) * rs * g1.y + b1.y); o.w = pk2((bflo(w.w) - mu) * rs * g1.z + b1.z, (bfhi(w.w) - mu) * rs * g1.w + b1.w);
                    *(LAS u32x4*)(lds + sgu::IMG_OFF + sgu::img_off(s, d)) = o; }
            }
            __syncthreads();
            f32x16 acc[2];
#pragma unroll
            for (int r = 0; r < 16; ++r) { acc[0][r] = 0.f; acc[1][r] = 0.f; }
            const bf16_t* arow = WSB + (size_t)(h * 128 + 32 * tb + r32) * 128 + 4 * hi;
            for (int ks = 0; ks < 2 * (tb + 1); ++ks) {
                const u32x2 alo = *(const u32x2*)(arow + 16 * ks), ahi = *(const u32x2*)(arow + 16 * ks + 8);
                const bf16x8 af = __builtin_bit_cast(bf16x8, (u32x4){alo.x, alo.y, ahi.x, ahi.y});
#pragma unroll
                for (int dd = 0; dd < 2; ++dd) { const int vb = vb0 + ((ks >> 2) * 4 + dh * 2 + dd) * 4096 + (ks & 3) * 1024; s16x4 blo, bhi;
                    asm volatile("ds_read_b64_tr_b16 %0,%1" : "=&v"(blo) : "v"(vb) : "memory");
                    asm volatile("ds_read_b64_tr_b16 %0,%1 offset:512" : "=&v"(bhi) : "v"(vb) : "memory");
                    asm volatile("s_waitcnt lgkmcnt(0)" ::: "memory"); __builtin_amdgcn_sched_barrier(0);
                    const bf16x8 bfr = (bf16x8){blo[0], blo[1], blo[2], blo[3], bhi[0], bhi[1], bhi[2], bhi[3]};
                    acc[dd] = __builtin_amdgcn_mfma_f32_32x32x16_bf16(af, bfr, acc[dd], 0, 0, 0); }
            }
#pragma unroll
            for (int r = 0; r < 16; ++r) { const int trow = att::crow(r, hi); const float bs = sbs[h * 128 + 32 * tb + trow];
                stg[trow * 64 + r32] = acc[0][r] + bs; stg[trow * 64 + 32 + r32] = acc[1][r] + bs; }
            LDS_WAIT();
#pragma unroll
            for (int i = 0; i < 4; ++i) { const int row = i * 8 + (lane >> 3), c8 = lane & 7; const size_t go = (size_t)(row0 + 32 * tb + row) * 1024 + h * 128 + dh * 64 + c8 * 8;
                const f32x4 m0 = *(const LAS f32x4*)(stg + row * 64 + c8 * 8), m1 = *(const LAS f32x4*)(stg + row * 64 + c8 * 8 + 4); const u32x4 u = *(const u32x4*)(U + go); u32x4 o;
                o.x = pk2(bflo(u.x) * m0.x, bfhi(u.x) * m0.y); o.y = pk2(bflo(u.y) * m0.z, bfhi(u.y) * m0.w); o.z = pk2(bflo(u.z) * m1.x, bfhi(u.z) * m1.y); o.w = pk2(bflo(u.w) * m1.z, bfhi(u.w) * m1.w);
                *(u32x4*)(MIX + go) = o; }
            __syncthreads();
        }
    }
}

__device__ __forceinline__ void ph_route(KA a, LAS unsigned char* lds, int layer) {
    const int tid = threadIdx.x, lane = tid & 63, wave = __builtin_amdgcn_readfirstlane(tid >> 6);
    LAS float* Wr = (LAS float*)lds;
    LAS int* s_bucket = (LAS int*)(lds + 81920); LAS float* s_cw = (LAS float*)(lds + 81920 + 512); LAS int* s_base = (LAS int*)(lds + 81920 + 512 + 1024);
    const float* gffn = a.in(I_GFFN) + layer * 1024;
    const float* wg = a.in(I_WGR) + (size_t)layer * 1024 * 4; const float* we = a.in(I_WER) + (size_t)layer * 4 * 1024 * 4;
    const float* bg = a.in(I_BGR) + layer * 4; const float* be = a.in(I_BER) + layer * 16;
    for (int i = tid; i < 4096; i += 512) { const int k = i >> 2, o = i & 3; Wr[o * 1024 + k] = wg[i] * gffn[k]; }
    for (int i = tid; i < 16384; i += 512) { const int g = i >> 12, k = (i >> 2) & 1023, o = i & 3; Wr[(4 + g * 4 + o) * 1024 + k] = we[i] * gffn[k]; }
    __syncthreads();
    unsigned char* ws = a.ws();
    const float* H = a.out(); bf16_t* XN = (bf16_t*)(ws + WS_XN);
    int* toklist = (int*)(ws + WS_TOK); f32x2* cwl = (f32x2*)(ws + WS_CW);
    unsigned* counts = (unsigned*)(ws + WS_CTL) + CW_CNT + 64 * layer;
    for (int tg = blockIdx.x; tg < NTOK / 128; tg += gridDim.x) {
        for (int ti = 0; ti < 16; ++ti) {
            const int lt = wave * 16 + ti, tok = tg * 128 + lt;
            const f32x4* xr = (const f32x4*)(H + (size_t)tok * 1024) + lane; f32x4 v[4]; float ss = 0.f;
#pragma unroll
            for (int j = 0; j < 4; ++j) { v[j] = xr[64 * j]; ss += (v[j].x * v[j].x + v[j].y * v[j].y) + (v[j].z * v[j].z + v[j].w * v[j].w); }
            float gl[4];
#pragma unroll
            for (int o = 0; o < 4; ++o) { float d = 0.f;
#pragma unroll
                for (int j = 0; j < 4; ++j) { const f32x4 w = *(const LAS f32x4*)(Wr + o * 1024 + 256 * j + 4 * lane); d += (v[j].x * w.x + v[j].y * w.y) + (v[j].z * w.z + v[j].w * w.w); }
                gl[o] = wave_sum(d); }
            const float r = 1.0f / sqrtf(wave_sum(ss) * (1.0f / 1024.0f) + EPS);
#pragma unroll
            for (int o = 0; o < 4; ++o) gl[o] = gl[o] * r + bg[o];
            int g = 0; float gm = gl[0];
#pragma unroll
            for (int o = 1; o < 4; ++o) if (gl[o] > gm) { gm = gl[o]; g = o; }
            float gs = 0.f;
#pragma unroll
            for (int o = 0; o < 4; ++o) gs += __expf(gl[o] - gm);
            const float gw_ = 1.0f / gs;
            g = __builtin_amdgcn_readfirstlane(g);
            float el[4];
#pragma unroll
            for (int o = 0; o < 4; ++o) { float d = 0.f;
#pragma unroll
                for (int j = 0; j < 4; ++j) { const f32x4 w = *(const LAS f32x4*)(Wr + (4 + g * 4 + o) * 1024 + 256 * j + 4 * lane); d += (v[j].x * w.x + v[j].y * w.y) + (v[j].z * w.z + v[j].w * w.w); }
                el[o] = wave_sum(d) * r + be[g * 4 + o]; }
            int e1 = 0; float m1 = el[0];
#pragma unroll
            for (int o = 1; o < 4; ++o) if (el[o] > m1) { m1 = el[o]; e1 = o; }
            int e2 = -1; float m2 = -3.0e38f;
#pragma unroll
            for (int o = 0; o < 4; ++o) if (o != e1 && el[o] > m2) { m2 = el[o]; e2 = o; }
            const float w2 = 1.0f / (1.0f + __expf(m1 - m2)), w1 = 1.0f - w2;
            const int lo = e1 < e2 ? e1 : e2, hi = e1 < e2 ? e2 : e1;
            const float cwlo = gw_ * (e1 < e2 ? w1 : w2), cwhi = gw_ * (e1 < e2 ? w2 : w1);
            const int pidx = lo == 0 ? hi - 1 : (lo == 1 ? hi + 1 : 5);
            if (lane == 0) { s_bucket[lt] = g * 6 + pidx; s_cw[lt * 2] = cwlo; s_cw[lt * 2 + 1] = cwhi; }
            unsigned long long* o8 = (unsigned long long*)(XN + (size_t)tok * 1024) + lane;
#pragma unroll
            for (int j = 0; j < 4; ++j) o8[64 * j] = (unsigned long long)pk2(v[j].x * r, v[j].y * r) | ((unsigned long long)pk2(v[j].z * r, v[j].w * r) << 32);
        }
        __syncthreads();
        if (tid < NBUCKET) { int c = 0; for (int i = 0; i < 128; ++i) c += (s_bucket[i] == tid) ? 1 : 0;
            s_base[tid] = c ? (int)__hip_atomic_fetch_add(counts + tid, (unsigned)c, RLX_AGENT) : 0; }
        __syncthreads();
        if (tid < 128) { const int b = s_bucket[tid]; int rank = 0; for (int i = 0; i < tid; ++i) rank += (s_bucket[i] == b) ? 1 : 0;
            const int pos = s_base[b] + rank; toklist[b * NTOK + pos] = tg * 128 + tid; cwl[b * NTOK + pos] = (f32x2){s_cw[tid * 2], s_cw[tid * 2 + 1]}; }
        __syncthreads();
    }
}
__device__ __forceinline__ MoeTab moe_table(KA a, LAS unsigned char* lds, int layer) {
    LAS int* tb = (LAS int*)(lds + TAB_OFF); LAS int* tf = tb + 160; LAS int* cnt = tf + 160; LAS int* tt = cnt + 24;
    __syncthreads();
    if (threadIdx.x == 0) { unsigned* counts = (unsigned*)(a.ws() + WS_CTL) + CW_CNT + 64 * layer; int t = 0;
        for (int b = 0; b < NBUCKET; ++b) { const int c = (int)__hip_atomic_load(counts + b, RLX_AGENT); cnt[b] = c; const int n = (c + 255) >> 8;
            for (int i = 0; i < n; ++i) { tb[t] = b; tf[t] = i; ++t; } }
        tt[0] = t; }
    __syncthreads();
    MoeTab m; m.tb = tb; m.tf = tf; m.cnt = cnt; m.T = __builtin_amdgcn_readfirstlane(tt[0]); return m;
}

__device__ __forceinline__ void ph_sgu_naive(KA a, LAS unsigned char* lds) {
    unsigned char* ws = a.ws();
    const bf16_t* U = (const bf16_t*)(ws + WS_U); const bf16_t* V1 = (const bf16_t*)(ws + WS_V1); const bf16_t* WSB = (const bf16_t*)(ws + WS_WS);
    bf16_t* MIX = (bf16_t*)(ws + WS_MIX); const float* slng = a.in(I_SLNG); const float* slnb = a.in(I_SLNB); const float* sbs = a.in(I_SBS);
    const int tid = threadIdx.x, lane = tid & 63, wave = __builtin_amdgcn_readfirstlane(tid >> 6);
    LAS float* mu = (LAS float*)lds; LAS float* rs = mu + 128;
    for (int un = blockIdx.x; un < NBATCH * 32 * 8; un += gridDim.x) {
        const int h = un & 7, bc = un >> 3, row0 = bc * 128;
        __syncthreads();
        for (int i = 0; i < 16; ++i) { const int rr = wave * 16 + i; const u32x4* vr = (const u32x4*)(V1 + (size_t)(row0 + rr) * 1024) + lane * 2; float s = 0.f, q = 0.f;
#pragma unroll
            for (int c = 0; c < 2; ++c) { const u32x4 w = vr[c];
#pragma unroll
                for (int j = 0; j < 4; ++j) { const float x0 = bflo(w[j]), x1 = bfhi(w[j]); s += x0 + x1; q += x0 * x0 + x1 * x1; } }
            s = wave_sum(s); q = wave_sum(q); const float mean = s * (1.0f / 1024.0f), var = q * (1.0f / 1024.0f) - mean * mean;
            if (lane == 0) { mu[rr] = mean; rs[rr] = 1.0f / sqrtf(var + EPS); } }
        __syncthreads();
        const int c = tid & 127, col = h * 128 + c; const float lg = slng[col], lb = slnb[col];
        for (int tt = tid >> 7; tt < 128; tt += 4) { float acc = 0.f;
            for (int s = 0; s <= tt; ++s) { const float vv = bf2f(V1[(size_t)(row0 + s) * 1024 + col]); const float vln = (vv - mu[s]) * rs[s] * lg + lb;
                acc += bf2f(WSB[(h * 128 + tt) * 128 + s]) * vln; }
            const float mixed = acc + sbs[h * 128 + tt]; const float u = bf2f(U[(size_t)(row0 + tt) * 1024 + col]);
            MIX[(size_t)(row0 + tt) * 1024 + col] = (bf16_t)f2bf(u * mixed); }
    }
    __syncthreads();
}

__device__ __forceinline__ void ph_norm_xn(KA a) {
    const int lane = threadIdx.x & 63, wave = __builtin_amdgcn_readfirstlane(threadIdx.x >> 6), gw = blockIdx.x * 8 + wave, NGW = gridDim.x * 8;
    bf16_t* XN = (bf16_t*)(a.ws() + WS_XN); const float* H = a.out();
    for (int m = gw; m < NTOK; m += NGW) rms_row_bf16(H + (size_t)m * 1024, XN + (size_t)m * 1024, lane);
}
__device__ __forceinline__ void ph_final_norm(KA a) {
    const int lane = threadIdx.x & 63, wave = __builtin_amdgcn_readfirstlane(threadIdx.x >> 6), gw = blockIdx.x * 8 + wave, NGW = gridDim.x * 8;
    const f32x4* gp = (const f32x4*)a.in(I_GFIN) + lane; f32x4 gg[4]; float* H = a.out();
#pragma unroll
    for (int j = 0; j < 4; ++j) gg[j] = gp[64 * j];
    for (int m = gw; m < NTOK; m += NGW) {
        f32x4* xr = (f32x4*)(H + (size_t)m * 1024) + lane; f32x4 v[4]; float s = 0.f;
#pragma unroll
        for (int j = 0; j < 4; ++j) { v[j] = xr[64 * j]; s += (v[j].x * v[j].x + v[j].y * v[j].y) + (v[j].z * v[j].z + v[j].w * v[j].w); }
        const float r = 1.0f / sqrtf(wave_sum(s) * (1.0f / 1024.0f) + EPS);
#pragma unroll
        for (int j = 0; j < 4; ++j) xr[64 * j] = v[j] * r * gg[j];
    }
}

__global__ void __launch_bounds__(512, 2) mk_fwd(Args args) {
    extern __shared__ __attribute__((aligned(16))) unsigned char lds_raw[];
    LAS unsigned char* lds = (LAS unsigned char*)lds_raw;
    const int tid = threadIdx.x;
    volatile LAS unsigned* MISC = (volatile LAS unsigned*)(lds + MISC_OFF);
    for (int u = tid; u < 64; u += 512) MISC[u] = 0u;
    __syncthreads();
    const KA ka{};
    XcdBarrier bar; bar.bar = nullptr; bar.x = 0; bar.st = nullptr;
    if (MK_N_LAUNCHES == 1) bar = xcd_barrier_post((unsigned*)(ka.ws() + WS_CTL) + CW_BAR, MISC + 8);
    const int lo = args.ph_lo, hi = args.ph_hi;
#define IN(k) (lo <= (k) && (k) < hi)
#define SEAM(k) do { if (IN(k) && IN((k) + 1)) xcd_barrier(bar); } while (0)
#define WSP(T, off) ((T*)(ws + (off)))

    if (IN(0)) { ph_prep(ka, lds); } SEAM(0);
    if (IN(1)) { unsigned char* ws = ka.ws(); ProbDense P{WSP(const bf16_t, WS_XN), WSP(const bf16_t, WS_BT_IN), 1024, 1024, 1024, 128, 8}; EpiIn E{WSP(bf16_t, WS_P)}; run_gemm(lds, P, E); } SEAM(1);
    if (IN(2)) { ph_pool(ka);
#if NAIVE_ATTN
        ph_attn_naive(ka);
#else
        ph_attn(ka, lds);
#endif
    } SEAM(2);
    if (IN(3)) { unsigned char* ws = ka.ws(); ProbDense P{WSP(const bf16_t, WS_MIX), WSP(const bf16_t, WS_BT_OUT), 1024, 1024, 1024, 128, 4}; EpiRes E{ka.in(I_X), ka.out()}; run_gemm(lds, P, E); } SEAM(3);
#define MOE_LAYER(layer, pb) do { \
        if (IN(pb)) { ph_route(ka, lds, layer); } SEAM(pb); \
        if (IN((pb) + 1)) { const MoeTab tab = moe_table(ka, lds, layer); unsigned char* ws = ka.ws(); \
            ProbGU P{WSP(const bf16_t, WS_XN), WSP(const bf16_t, WS_GU + (size_t)(layer) * 16 * MiB), WSP(const int, WS_TOK), tab, 1024, 1024, 1024}; EpiGU E{WSP(bf16_t, WS_ACT), WSP(const f32x2, WS_CW), tab}; run_gemm(lds, P, E); } SEAM((pb) + 1); \
        if (IN((pb) + 2)) { const MoeTab tab = moe_table(ka, lds, layer); unsigned char* ws = ka.ws(); \
            ProbDN P{WSP(const bf16_t, WS_ACT), WSP(const bf16_t, WS_DN + (size_t)(layer) * 24 * MiB), tab, 512, 512, 512}; EpiDN E{ka.out(), WSP(const int, WS_TOK), tab}; run_gemm(lds, P, E); } SEAM((pb) + 2); } while (0)
    MOE_LAYER(0, 4);
    if (IN(7)) { ph_norm_xn(ka); } SEAM(7);
    if (IN(8)) { unsigned char* ws = ka.ws(); ProbDense P{WSP(const bf16_t, WS_XN), WSP(const bf16_t, WS_BT_SIN), 1024, 1024, 1024, 128, 8}; EpiSin E{WSP(bf16_t, WS_U), WSP(bf16_t, WS_V1), ka.in(I_SBIN)}; run_gemm(lds, P, E); } SEAM(8);
    if (IN(9)) {
#if NAIVE_SGU
        ph_sgu_naive(ka, lds);
#else
        ph_sgu(ka, lds);
#endif
    } SEAM(9);
    if (IN(10)) { unsigned char* ws = ka.ws(); float* H = ka.out(); ProbDense P{WSP(const bf16_t, WS_MIX), WSP(const bf16_t, WS_BT_SOUT), 1024, 1024, 1024, 128, 4}; EpiRes E{H, H}; run_gemm(lds, P, E); } SEAM(10);
    MOE_LAYER(1, 11);
#undef MOE_LAYER
    if (IN(14)) { ph_final_norm(ka); }
#undef IN
#undef SEAM
#undef WSP
}

extern "C" void kernel_launch(void* const* d_in, const int* in_sizes, int n_in, void* d_out, int out_size, void* d_ws, size_t ws_size, hipStream_t stream) {
    static int grid = 0;
    if (grid == 0) {
        if (n_in != 23 || out_size != NTOK * DM || ws_size < WS_END) { fprintf(stderr, "kernel_launch: unexpected shapes (n_in %d out %d ws %zu)\n", n_in, out_size, ws_size); grid = -1; return; }
        int dev = 0, cus = 0, per_cu = 0;
        if (hipGetDevice(&dev) != hipSuccess || hipDeviceGetAttribute(&cus, hipDeviceAttributeMultiprocessorCount, dev) != hipSuccess) { grid = -1; return; }
        if (hipFuncSetAttribute((const void*)mk_fwd, hipFuncAttributeMaxDynamicSharedMemorySize, LDS_BYTES) != hipSuccess) { fprintf(stderr, "kernel_launch: hipFuncSetAttribute failed\n"); grid = -1; return; }
        if (hipOccupancyMaxActiveBlocksPerMultiprocessor(&per_cu, (const void*)mk_fwd, 512, LDS_BYTES) != hipSuccess || per_cu < 1) { fprintf(stderr, "kernel_launch: occupancy query says %d\n", per_cu); }
        (void)hipGetLastError();
        grid = cus;
    }
    if (grid < 0) return;
    (void)hipMemsetAsync((char*)d_ws + WS_CTL, 0, CTL_ZERO_BYTES, stream);
    Args a{};
    for (int i = 0; i < 23; ++i) a.in[i] = (const float*)d_in[i];
    a.out = (float*)d_out; a.ws = (unsigned char*)d_ws;
    if (MK_N_LAUNCHES == 1) { a.ph_lo = 0; a.ph_hi = NPHASE; hipLaunchKernelGGL(mk_fwd, dim3(grid), dim3(512), LDS_BYTES, stream, a); }
    else { for (int p = 0; p < NPHASE; ++p) { a.ph_lo = p; a.ph_hi = p + 1; hipLaunchKernelGGL(mk_fwd, dim3(grid), dim3(512), LDS_BYTES, stream, a); } }
}
```
